# Optimizing an MI355X kernel written in HIP

```python
import math
import jax, jax.numpy as jnp
from jax import lax
import numpy as np

D_MODEL = 4096
BATCH = 4
SEQ = 4096
DEPTH = 1

HEAD_DIM = 128
MOBA_HEADS = 16
FOX_HEADS = 16
MOBA_WIDTH = MOBA_HEADS * HEAD_DIM
FOX_WIDTH = FOX_HEADS * HEAD_DIM
MOBA_BLOCK = 256
MOBA_TOPK = 3
MOBA_Q_CHUNK = 16
FOX_Q_BLOCK = 128
T5_NUM_BUCKETS = 32
T5_MAX_DISTANCE = 128
LN_EPS = 1e-5
FORGET_BIAS_INIT = 3.0
DEEPNORM_ALPHA = (2.0 * DEPTH) ** 0.25
DEEPNORM_BETA = (8.0 * DEPTH) ** -0.25
IN_SIZES = [MOBA_WIDTH] * 4 + [FOX_WIDTH] * 4 + [FOX_HEADS, 2 * D_MODEL]
IN_COLS = int(sum(IN_SIZES))
IN_SPLITS = [int(v) for v in np.cumsum(IN_SIZES)[:-1]]

kernel_name = "moba_fox_gated_hybrid_deepnorm"


def t5_bucket(dist):
    max_exact = T5_NUM_BUCKETS // 2
    d = jnp.maximum(dist, 1).astype(jnp.float32)
    large = max_exact + (jnp.log(d / max_exact) / math.log(T5_MAX_DISTANCE / max_exact)
                         * (T5_NUM_BUCKETS - max_exact)).astype(jnp.int32)
    large = jnp.minimum(large, T5_NUM_BUCKETS - 1)
    return jnp.where(dist < max_exact, dist, large)


def moba_attention(q, k, v, rel_bias_table):
    B, H, S, Dh = q.shape
    nb = -(-S // MOBA_BLOCK)
    pad = nb * MOBA_BLOCK - S
    kp = jnp.pad(k, ((0, 0), (0, 0), (0, pad), (0, 0)))
    vp = jnp.pad(v, ((0, 0), (0, 0), (0, pad), (0, 0)))
    kb = kp.reshape(B, H, nb, MOBA_BLOCK, Dh)
    vb = vp.reshape(B, H, nb, MOBA_BLOCK, Dh)
    k_mean = jnp.mean(kb.astype(jnp.float32), axis=3)
    bias_hb = rel_bias_table.T.astype(jnp.float32)
    scale = HEAD_DIM ** -0.5
    topk = min(MOBA_TOPK, nb)
    C = MOBA_Q_CHUNK
    n_chunks = S // C
    qc = q.reshape(B, H, n_chunks, C, Dh).transpose(2, 0, 1, 3, 4)
    b_idx = jnp.arange(B)[:, None, None, None]
    h_idx = jnp.arange(H)[None, :, None, None]
    blk_ar = jnp.arange(MOBA_BLOCK, dtype=jnp.int32)

    def chunk(args):
        ci, qi = args
        q_pos = ci * C + jnp.arange(C, dtype=jnp.int32)
        own = (ci * C) // MOBA_BLOCK
        gate = jnp.einsum("bhcd,bhnd->bhcn", qi.astype(jnp.float32), k_mean)
        past = jnp.arange(nb)[None, :] < own
        gate = jnp.where(past[None, None], gate, -1e30)
        _, sel = lax.top_k(gate, topk)
        slot_valid = jnp.arange(topk) < own
        sel = jnp.where(slot_valid, sel, 0)
        k_sel = kb[b_idx, h_idx, sel].reshape(B, H, C, topk * MOBA_BLOCK, Dh)
        v_sel = vb[b_idx, h_idx, sel].reshape(B, H, C, topk * MOBA_BLOCK, Dh)
        s_sel = jnp.einsum("bhcd,bhckd->bhck", qi, k_sel).astype(jnp.float32) * scale
        key_pos_sel = (sel[..., None] * MOBA_BLOCK + blk_ar).reshape(B, H, C, topk * MOBA_BLOCK)
        dist_sel = jnp.maximum(q_pos[:, None] - key_pos_sel, 0)
        s_sel = s_sel + bias_hb[h_idx, t5_bucket(dist_sel)]
        valid_sel = jnp.repeat(slot_valid, MOBA_BLOCK)
        s_sel = jnp.where(valid_sel, s_sel, -jnp.inf)
        k_own = lax.dynamic_index_in_dim(kb, own, axis=2, keepdims=False)
        v_own = lax.dynamic_index_in_dim(vb, own, axis=2, keepdims=False)
        s_own = jnp.einsum("bhcd,bhkd->bhck", qi, k_own).astype(jnp.float32) * scale
        dist_own = q_pos[:, None] - (own * MOBA_BLOCK + blk_ar)[None, :]
        s_own = s_own + bias_hb[:, t5_bucket(jnp.maximum(dist_own, 0))]
        s_own = jnp.where(dist_own >= 0, s_own, -jnp.inf)
        p = jax.nn.softmax(jnp.concatenate([s_sel, s_own], axis=-1), axis=-1).astype(v.dtype)
        p_sel, p_own = p[..., :topk * MOBA_BLOCK], p[..., topk * MOBA_BLOCK:]
        return (jnp.einsum("bhck,bhckd->bhcd", p_sel, v_sel)
                + jnp.einsum("bhck,bhkd->bhcd", p_own, v_own))

    out = lax.map(chunk, (jnp.arange(n_chunks, dtype=jnp.int32), qc))
    return out.transpose(1, 2, 0, 3, 4).reshape(B, H, S, Dh)


def forgetting_attention(q, k, v, log_f):
    B, H, S, Dh = q.shape
    c = jnp.cumsum(log_f, axis=-1)
    nqb = S // FOX_Q_BLOCK
    qb = q.reshape(B, H, nqb, FOX_Q_BLOCK, Dh).transpose(2, 0, 1, 3, 4)
    cb = c.reshape(B, H, nqb, FOX_Q_BLOCK).transpose(2, 0, 1, 3)
    key_pos = jnp.arange(S, dtype=jnp.int32)
    scale = HEAD_DIM ** -0.5

    def block(args):
        bi, qi, ci = args
        q_pos = bi * FOX_Q_BLOCK + jnp.arange(FOX_Q_BLOCK, dtype=jnp.int32)
        s = jnp.einsum("bhqd,bhkd->bhqk", qi, k).astype(jnp.float32) * scale
        s = s + ci[..., None] - c[:, :, None, :]
        s = jnp.where(key_pos[None, :] <= q_pos[:, None], s, -jnp.inf)
        p = jax.nn.softmax(s, axis=-1).astype(v.dtype)
        return jnp.einsum("bhqk,bhkd->bhqd", p, v)

    out = lax.map(block, (jnp.arange(nqb, dtype=jnp.int32), qb, cb))
    return out.transpose(1, 2, 0, 3, 4).reshape(B, H, S, Dh)


def layer_norm(h, gain, bias):
    hf = h.astype(jnp.float32)
    mu = jnp.mean(hf, axis=-1, keepdims=True)
    var = jnp.mean(jnp.square(hf - mu), axis=-1, keepdims=True)
    return ((hf - mu) * lax.rsqrt(var + LN_EPS) * gain + bias).astype(h.dtype)


def setup_inputs(seed: int = 0) -> dict:
    key = jax.random.key(seed)
    ks = jax.random.split(key, 10)
    x = jax.random.normal(ks[0], (BATCH, SEQ, D_MODEL), jnp.float32)
    col_scale = jnp.concatenate([
        jnp.ones((2 * MOBA_WIDTH,)), jnp.full((MOBA_WIDTH,), DEEPNORM_BETA), jnp.ones((MOBA_WIDTH,)),
        jnp.ones((2 * FOX_WIDTH,)), jnp.full((FOX_WIDTH,), DEEPNORM_BETA), jnp.ones((FOX_WIDTH,)),
        jnp.ones((FOX_HEADS + 2 * D_MODEL,))]).astype(jnp.float32)
    w_in = jax.random.normal(ks[1], (DEPTH, D_MODEL, IN_COLS), jnp.float32) * D_MODEL ** -0.5 * col_scale
    b_forget = FORGET_BIAS_INIT + 0.1 * jax.random.normal(ks[2], (DEPTH, FOX_HEADS), jnp.float32)
    b_gate = 0.1 * jax.random.normal(ks[3], (DEPTH, 2, D_MODEL), jnp.float32)
    rel_bias_table = 0.5 * jax.random.normal(ks[4], (T5_NUM_BUCKETS, MOBA_HEADS), jnp.float32)
    w_branch = (jax.random.normal(ks[5], (DEPTH, 2, MOBA_WIDTH, D_MODEL), jnp.float32)
                * MOBA_WIDTH ** -0.5 * DEEPNORM_BETA)
    w_out = jax.random.normal(ks[6], (DEPTH, D_MODEL, D_MODEL), jnp.float32) * D_MODEL ** -0.5 * DEEPNORM_BETA
    ln_gain = 1.0 + 0.1 * jax.random.normal(ks[7], (DEPTH, D_MODEL), jnp.float32)
    ln_bias = 0.1 * jax.random.normal(ks[8], (DEPTH, D_MODEL), jnp.float32)
    return {"x": x, "w_in": w_in, "b_forget": b_forget, "b_gate": b_gate,
            "rel_bias_table": rel_bias_table, "w_branch": w_branch, "w_out": w_out,
            "ln_gain": ln_gain, "ln_bias": ln_bias}


def reference(x, w_in, b_forget, b_gate, rel_bias_table, w_branch, w_out, ln_gain, ln_bias):
    B, S, D = x.shape

    def heads(t, H):
        return t.reshape(B, S, H, HEAD_DIM).transpose(0, 2, 1, 3)

    def merge_heads(t):
        return t.transpose(0, 2, 1, 3).reshape(B, S, -1)

    for layer in range(DEPTH):
        proj = jnp.einsum("bsd,de->bse", x, w_in[layer])
        qa, ka, va, za, qf, kf, vf, zf, f_logit, g_logit = jnp.split(proj, IN_SPLITS, axis=-1)
        ya = merge_heads(moba_attention(heads(qa, MOBA_HEADS), heads(ka, MOBA_HEADS),
                                        heads(va, MOBA_HEADS), rel_bias_table))
        ya = ya * jax.nn.silu(za)
        log_f = jax.nn.log_sigmoid(f_logit.astype(jnp.float32) + b_forget[layer]).transpose(0, 2, 1)
        yf = merge_heads(forgetting_attention(heads(qf, FOX_HEADS), heads(kf, FOX_HEADS),
                                              heads(vf, FOX_HEADS), log_f))
        yf = yf * jax.nn.silu(zf)
        ua = jnp.einsum("bsw,wd->bsd", ya, w_branch[layer, 0])
        uf = jnp.einsum("bsw,wd->bsd", yf, w_branch[layer, 1])
        gates = jax.nn.sigmoid(g_logit.reshape(B, S, 2, D) + b_gate[layer])
        merged = gates[:, :, 0] * ua + gates[:, :, 1] * uf
        out = jnp.einsum("bsd,de->bse", merged, w_out[layer])
        x = layer_norm(DEEPNORM_ALPHA * x + out, ln_gain[layer], ln_bias[layer])
    return x
```

```cpp
#include <hip/hip_runtime.h>
#include <hip/hip_cooperative_groups.h>
#include <cstdio>
#include <cstdint>
namespace cg = cooperative_groups;

#define LAS __attribute__((address_space(3)))
typedef unsigned short bf16_t;
typedef short bf16x8 __attribute__((ext_vector_type(8)));
typedef short s16x4 __attribute__((ext_vector_type(4)));
typedef float f32x2 __attribute__((ext_vector_type(2)));
typedef float f32x4 __attribute__((ext_vector_type(4)));
typedef float f32x16 __attribute__((ext_vector_type(16)));
typedef unsigned u32x2 __attribute__((ext_vector_type(2)));
typedef unsigned u32x4 __attribute__((ext_vector_type(4)));

constexpr int SEQ = 4096, DM = 4096, NTOK = 16384, NH = 16;
constexpr int INCOLS = 24592;
constexpr int LDP = 24576;
constexpr int COL_QA = 0, COL_KA = 2048, COL_VA = 4096, COL_ZA = 6144, COL_QF = 8192, COL_KF = 10240, COL_VF = 12288, COL_ZF = 14336,
              COL_G0 = 16384, COL_G1 = 20480;
constexpr float LOG2E = 1.4426950408889634f;
constexpr float ATT_SCALE = 0.08838834764831845f;
constexpr float DN_ALPHA = 1.189207115002721f;
constexpr float LN_EPS = 1e-5f;
constexpr int LDS_BYTES = 140 * 1024;
constexpr float SC_Y = 8.f, SC_WB = 64.f, SC_M = 64.f, SC_WO = 64.f, SC_W1 = 64.f;
constexpr size_t HM_REG = (size_t)NTOK * 2048;
constexpr int LDG = 8192;

struct Params {
    const float* x; const float* w_in; const float* b_forget; const float* b_gate; const float* rel_bias; const float* w_branch; const float* w_out;
    const float* ln_gain; const float* ln_bias;
    float* out;
    bf16_t* xb; bf16_t* WinT; bf16_t* WbrT; bf16_t* WoutT; bf16_t* hm; bf16_t* gbuf; bf16_t* Y; bf16_t* merged; bf16_t* outb; unsigned char* x8; unsigned char* WinT8;
    float* kmean; float* flogT;
};

__device__ __forceinline__ unsigned cvt_pk_bf16(float lo, float hi) { unsigned r; asm volatile("v_cvt_pk_bf16_f32 %0, %1, %2" : "=v"(r) : "v"(lo), "v"(hi)); return r; }
__device__ __forceinline__ unsigned pk4_fp8(float a, float b, float c, float d) { int w = __builtin_amdgcn_cvt_pk_fp8_f32(a, b, 0, false); w = __builtin_amdgcn_cvt_pk_fp8_f32(c, d, w, true); return (unsigned)w; }
__device__ __forceinline__ float bf2f(bf16_t b) { return __uint_as_float(((unsigned)b) << 16); }
__device__ __forceinline__ float bflo(unsigned w) { return __uint_as_float(w << 16); }
__device__ __forceinline__ float bfhi(unsigned w) { return __uint_as_float(w & 0xffff0000u); }

namespace pg8 {
constexpr int BM = 256, BK = 64, HALF = 128, HTB = HALF * BK * 2, STAGE_BYTES = 8 * HTB, NXCD = 8, WGM = 8;
__host__ __device__ __forceinline__ int lds_byte(int r, int c) { const int st = (r >> 4) * 2 + (c >> 5), rr = r & 15, cc = c & 31, ob = rr * 64 + cc * 2; return st * 1024 + (ob ^ (((ob >> 9) & 1) << 5)); }
__host__ __device__ __forceinline__ void stage_rc(int b, int& R, int& C) { const int st = b / 1024, sb = b % 1024, swz = sb ^ (((sb >> 9) & 1) << 5); R = (st >> 1) * 16 + swz / 64; C = (st & 1) * 32 + (swz % 64) / 2; }
__host__ __device__ __forceinline__ int perm32(int rho) { const int n = rho >> 4, i = rho & 15; return 8 * (i >> 2) + 4 * n + (i & 3); }
struct Unit { int pm, pn; };
struct Gemm { const bf16_t* A; const bf16_t* Bt; int M, N, K; };
struct StaticOrder {
    int nM, nN, nwg, G, c;
    __device__ void init(int M, int N, int G_, int c_) { nM = M / BM; nN = N / BM; nwg = nM * nN; G = G_; c = c_; }
    __device__ bool next(int i, Unit& u) const {
        const long L = (long)i * G + c; if (L >= nwg) return false;
        int wgid = (int)L; { const int q = nwg / NXCD, r = nwg % NXCD, xcd = wgid % NXCD, off = wgid / NXCD; wgid = (xcd < r ? xcd * (q + 1) : r * (q + 1) + (xcd - r) * q) + off; }
        const int nig = WGM * nN, gid = wgid / nig, fm = gid * WGM, gsz = (nM - fm) < WGM ? (nM - fm) : WGM;
        u.pm = fm + ((wgid % nig) % gsz); u.pn = (wgid % nig) / gsz; return true;
    }
};

typedef int i32x8 __attribute__((ext_vector_type(8)));
typedef int i32x4_t __attribute__((ext_vector_type(4)));
template <class Epi, bool MID, bool FP8 = false>
__device__ __forceinline__ void gemm_phase(LAS unsigned char* lds, const Gemm g, const StaticOrder& S, const Epi& E) {
    const int tid = threadIdx.x, wid = __builtin_amdgcn_readfirstlane(tid >> 6), lane = tid & 63, wr = wid >> 2, wc = wid & 3, fr = lane & 15, fq = lane >> 4;
    const int K = g.K, nt = K / BK;
    unsigned voffA[2], voffB[2];
#pragma unroll
    for (int i = 0; i < 2; ++i) { int R, C; stage_rc(tid * 16 + i * 8192, R, C); const int Rb = Epi::PERM ? ((R & ~31) + perm32(R & 31)) : R;
        voffA[i] = (unsigned)(R * K + C) * 2u; voffB[i] = (unsigned)(Rb * K + C) * 2u; }
    const size_t kstep = (size_t)(BK * 2);
    const size_t hstep = (size_t)HALF * K * 2;
    const size_t tstep = 2 * hstep;
    const unsigned ldsw = (unsigned)wid * 1024u;
    const int lds0 = (int)(unsigned)(uintptr_t)lds;
    const int aoff = lds0 + lds_byte(wr * 64 + fr, fq * 8), boff = lds0 + 4 * HTB + lds_byte(wc * 32 + fr, fq * 8);
#define PG8_SA(b, h) (((b) * 2 + (h)) * HTB)
#define PG8_SB(b, h) ((4 + (b) * 2 + (h)) * HTB)
#define PG8_STAGE(bufoff, gbase, voff) do { const long long d_ = (const char*)(gbase) - prev##voff; prev##voff = (const char*)(gbase); \
        _Pragma("unroll") for (int _i = 0; _i < 2; ++_i) { p##voff[_i] += d_; asm volatile("" : "+v"(p##voff[_i])); \
        __builtin_amdgcn_global_load_lds((const unsigned*)p##voff[_i], (LAS unsigned*)(lds + (bufoff) + ldsw + _i * 8192), 16, 0, 0); } } while (0)
#define PG8_DSR(dst, base, off) asm volatile("ds_read_b128 %0, %1 offset:%2" : "=v"(dst) : "v"(base), "i"(off))
#define PG8_LDA(dst, b, h) do { if constexpr (FP8) { _Pragma("unroll") for (int m = 0; m < 4; ++m) { i32x4_t lo_, hi_; PG8_DSR(lo_, aoff, PG8_SA(b, h) + m * 2048); PG8_DSR(hi_, aoff, PG8_SA(b, h) + m * 2048 + 1024); \
              dst##8[m] = __builtin_shufflevector(lo_, hi_, 0, 1, 2, 3, 4, 5, 6, 7); } } \
        else { _Pragma("unroll") for (int m = 0; m < 4; ++m) _Pragma("unroll") for (int k = 0; k < 2; ++k) PG8_DSR(dst[m][k], aoff, PG8_SA(b, h) + m * 2048 + k * 1024); } } while (0)
#define PG8_LDB(dst, b, h) do { if constexpr (FP8) { _Pragma("unroll") for (int n = 0; n < 2; ++n) { i32x4_t lo_, hi_; PG8_DSR(lo_, boff, PG8_SA(b, h) + n * 2048); PG8_DSR(hi_, boff, PG8_SA(b, h) + n * 2048 + 1024); \
              dst##8[n] = __builtin_shufflevector(lo_, hi_, 0, 1, 2, 3, 4, 5, 6, 7); } } \
        else { _Pragma("unroll") for (int n = 0; n < 2; ++n) _Pragma("unroll") for (int k = 0; k < 2; ++k) PG8_DSR(dst[n][k], boff, PG8_SA(b, h) + n * 2048 + k * 1024); } } while (0)
#define PG8_MMA(ai, bj, At, Bt) do { __builtin_amdgcn_s_setprio(1); _Pragma("unroll") for (int m = 0; m < 4; ++m) _Pragma("unroll") for (int n = 0; n < 2; ++n) { \
        if constexpr (FP8) { asm volatile("v_mfma_f32_16x16x128_f8f6f4 %0, %1, %2, %0" : "+v"(acc[ai][bj][m][n]) : "v"(Bt##8[n]), "v"(At##8[m])); }   \
        else { _Pragma("unroll") for (int k = 0; k < 2; ++k) acc[ai][bj][m][n] = __builtin_amdgcn_mfma_f32_16x16x32_bf16(Bt[n][k], At[m][k], acc[ai][bj][m][n], 0, 0, 0); } } \
        __builtin_amdgcn_s_setprio(0); } while (0)
#define PG8_WAIT_V(n) asm volatile("s_waitcnt vmcnt(" #n ")" ::: "memory")
#define PG8_WAIT_L(n) asm volatile("s_waitcnt lgkmcnt(" #n ")" ::: "memory")
#define PG8_BAR __builtin_amdgcn_s_barrier()
#define PG8_SCHED __builtin_amdgcn_sched_barrier(0)
#define PG8_KBODY(t) do { \
            const bool last = (t == nt - 2); \
            const char* a1 = cA + (size_t)(t + 1) * kstep; \
            const char* a2 = last ? nA : cA + (size_t)(t + 2) * kstep; const char* b2 = last ? nB : cB + (size_t)(t + 2) * kstep; \
            const char* a3 = a2 + kstep; const char* b3 = b2 + kstep; \
            PG8_LDB(B0, 0, 0); PG8_SCHED; PG8_LDA(At, 0, 0); PG8_STAGE(PG8_SA(1, 1), a1 + hstep, voffA); \
            PG8_WAIT_L(8); PG8_BAR; PG8_WAIT_L(0); PG8_MMA(0, 0, At, B0); PG8_BAR; PG8_SCHED; \
            PG8_LDB(B1, 0, 1); PG8_STAGE(PG8_SB(0, 0), b2, voffB); \
            PG8_BAR; PG8_WAIT_L(0); PG8_MMA(0, 1, At, B1); PG8_BAR; \
            PG8_LDA(At, 0, 1); PG8_STAGE(PG8_SA(0, 0), a2, voffA); \
            PG8_BAR; PG8_WAIT_L(0); PG8_MMA(1, 0, At, B0); PG8_BAR; PG8_SCHED; \
            PG8_STAGE(PG8_SB(0, 1), b2 + hstep, voffB); \
            PG8_WAIT_V(6); PG8_BAR; PG8_MMA(1, 1, At, B1); PG8_BAR; \
            PG8_LDB(B0, 1, 0); PG8_SCHED; PG8_LDA(At, 1, 0); PG8_STAGE(PG8_SA(0, 1), a2 + hstep, voffA); \
            PG8_WAIT_L(8); PG8_BAR; PG8_WAIT_L(0); PG8_MMA(0, 0, At, B0); PG8_BAR; PG8_SCHED; \
            PG8_LDB(B1, 1, 1); PG8_STAGE(PG8_SB(1, 0), b3, voffB); \
            PG8_BAR; PG8_WAIT_L(0); PG8_MMA(0, 1, At, B1); PG8_BAR; \
            PG8_LDA(At, 1, 1); PG8_STAGE(PG8_SA(1, 0), a3, voffA); \
            PG8_BAR; PG8_WAIT_L(0); PG8_MMA(1, 0, At, B0); PG8_BAR; PG8_SCHED; \
            PG8_STAGE(PG8_SB(1, 1), b3 + hstep, voffB); \
            PG8_WAIT_V(6); PG8_BAR; PG8_MMA(1, 1, At, B1); PG8_BAR; \
        } while (0)
    Unit cur, nxt; int ui = 0;
    if (!S.next(0, cur)) return;
    f32x4 acc[2][2][4][2];
#pragma unroll
    for (int a = 0; a < 2; ++a)
#pragma unroll
        for (int b = 0; b < 2; ++b)
#pragma unroll
            for (int m = 0; m < 4; ++m)
#pragma unroll
                for (int n = 0; n < 2; ++n) acc[a][b][m][n] = (f32x4){0.f, 0.f, 0.f, 0.f};
    bf16x8 At[4][2], B0[2][2], B1[2][2]; i32x8 At8[4], B08[2], B18[2];
    const char* cA = (const char*)g.A + (size_t)cur.pm * tstep; const char* cB = (const char*)g.Bt + (size_t)cur.pn * tstep;
    const char* prevvoffA = cA; const char* prevvoffB = cB;
    const char* pvoffA[2] = {cA + voffA[0], cA + voffA[1]}; const char* pvoffB[2] = {cB + voffB[0], cB + voffB[1]};
    PG8_STAGE(PG8_SB(0, 0), cB, voffB); PG8_STAGE(PG8_SA(0, 0), cA, voffA); PG8_STAGE(PG8_SB(0, 1), cB + hstep, voffB); PG8_STAGE(PG8_SA(0, 1), cA + hstep, voffA);
    if (wr == 1) PG8_BAR;
    PG8_WAIT_V(4); PG8_BAR;
    PG8_STAGE(PG8_SB(1, 0), cB + kstep, voffB); PG8_STAGE(PG8_SA(1, 0), cA + kstep, voffA); PG8_STAGE(PG8_SB(1, 1), cB + hstep + kstep, voffB);
    PG8_WAIT_V(6); PG8_BAR;
    for (;;) {
        const bool has_next = S.next(ui + 1, nxt);
        const char* nA = has_next ? (const char*)g.A + (size_t)nxt.pm * tstep : cA; const char* nB = has_next ? (const char*)g.Bt + (size_t)nxt.pn * tstep : cB;
        if constexpr (MID) {
            for (int t = 0; t < (nt >> 1); t += 2) PG8_KBODY(t);
            PG8_SCHED; if constexpr (FP8) { asm volatile("s_nop 15\n\ts_nop 15" ::: "memory"); } E.mid(acc, cur, wr, wc, fr, fq); PG8_SCHED;
            for (int t = (nt >> 1); t < nt; t += 2) PG8_KBODY(t);
        } else {
            for (int t = 0; t < nt; t += 2) PG8_KBODY(t);
        }
        if constexpr (FP8) { asm volatile("s_nop 15\n\ts_nop 15" ::: "memory"); }
        E(acc, cur, wr, wc, fr, fq);
        __builtin_amdgcn_s_waitcnt(0x0F70);
        if (!has_next) break;
#pragma unroll
        for (int a = 0; a < 2; ++a)
#pragma unroll
            for (int b = 0; b < 2; ++b)
#pragma unroll
                for (int m = 0; m < 4; ++m)
#pragma unroll
                    for (int n = 0; n < 2; ++n) acc[a][b][m][n] = (f32x4){0.f, 0.f, 0.f, 0.f};
        cur = nxt; cA = nA; cB = nB; ++ui;
    }
    PG8_WAIT_V(0);
    if (wr == 0) PG8_BAR;
    PG8_BAR;
#undef PG8_KBODY
#undef PG8_DSR
#undef PG8_SA
#undef PG8_SB
#undef PG8_STAGE
#undef PG8_LDA
#undef PG8_LDB
#undef PG8_MMA
#undef PG8_WAIT_V
#undef PG8_WAIT_L
#undef PG8_BAR
#undef PG8_SCHED
}

__device__ __forceinline__ float clampl(float l) { return fminf(fmaxf(l, -30.f), 30.f); }
struct EpiProj {
    static constexpr bool PERM = true;
    bf16_t* hm; bf16_t* gbuf; const float* b_gate; float* ksum; int mode; float scale;
    __device__ __forceinline__ void operator()(const f32x4 (&acc)[2][2][4][2], const Unit& un, int wr, int wc, int fr, int fq) const {
        Unit u; u.pm = un.pm; u.pn = mode ? un.pn + 16 : un.pn;
        const int row0 = u.pm * BM + wr * 64 + fr;
        if (u.pn >= 8 && u.pn < 16) {
#pragma unroll
            for (int bj = 0; bj < 2; ++bj)
#pragma unroll
                for (int n = 0; n < 2; ++n) { f32x4 sm = acc[0][bj][0][n];
#pragma unroll
                    for (int m = 1; m < 4; ++m) sm += acc[0][bj][m][n];
#pragma unroll
                    for (int m = 0; m < 4; ++m) sm += acc[1][bj][m][n];
#pragma unroll
                    for (int j = 0; j < 4; ++j) { float v = sm[j]; v += __shfl_xor(v, 1); v += __shfl_xor(v, 2); v += __shfl_xor(v, 4); v += __shfl_xor(v, 8);
                        if (fr == 0) atomicAdd(ksum + ((size_t)((u.pm >> 4) * NH + (u.pn - 8) * 2 + bj) * 16 + (u.pm & 15)) * 128 + wc * 32 + 8 * fq + 4 * n + j, v); } }
        }
        const bool isg = (u.pn >= 64);
        f32x4 bv[2][2];
#pragma unroll
        for (int bj = 0; bj < 2; ++bj)
#pragma unroll
            for (int n = 0; n < 2; ++n) bv[bj][n] = isg ? *(const f32x4*)(b_gate + (u.pn - 64) * BM + wc * 32 + 8 * fq + bj * HALF + 4 * n) : (f32x4){0.f, 0.f, 0.f, 0.f};
        bf16_t* base; size_t rstride, bjstride;
        if (isg) { base = gbuf + (size_t)row0 * LDG + (u.pn - 64) * BM + wc * 32 + 8 * fq; rstride = LDG; bjstride = HALF; }
        else { const int b = u.pm >> 4, s0 = (row0 & 4095); base = hm + (size_t)(u.pn >> 3) * HM_REG + ((size_t)(b * NH + (u.pn & 7) * 2) * SEQ + s0) * 128 + wc * 32 + 8 * fq; rstride = 128; bjstride = (size_t)SEQ * 128; }
#pragma unroll
        for (int ai = 0; ai < 2; ++ai)
#pragma unroll
            for (int m = 0; m < 4; ++m) { bf16_t* rowp = base + (size_t)(ai * HALF + m * 16) * rstride;
#pragma unroll
                for (int bj = 0; bj < 2; ++bj) { f32x4 v0 = acc[ai][bj][m][0] * scale, v1 = acc[ai][bj][m][1] * scale;
                    if (isg) {
#pragma unroll
                        for (int j = 0; j < 4; ++j) { v0[j] = __builtin_amdgcn_rcpf(1.f + __builtin_amdgcn_exp2f(-LOG2E * clampl(v0[j] + bv[bj][0][j])));
                                                      v1[j] = __builtin_amdgcn_rcpf(1.f + __builtin_amdgcn_exp2f(-LOG2E * clampl(v1[j] + bv[bj][1][j]))); } }
                    u32x4 w; w.x = cvt_pk_bf16(v0[0], v0[1]); w.y = cvt_pk_bf16(v0[2], v0[3]); w.z = cvt_pk_bf16(v1[0], v1[1]); w.w = cvt_pk_bf16(v1[2], v1[3]);
                    *(u32x4*)(rowp + bj * bjstride) = w; } }
    }
};
struct EpiMerged {
    static constexpr bool PERM = true;
    bf16_t* O; const bf16_t* gb;
    __device__ __forceinline__ void mid(f32x4 (&acc)[2][2][4][2], const Unit& u, int wr, int wc, int fr, int fq) const {
        const bf16_t* gp = gb + (size_t)(u.pm * BM + wr * 64 + fr) * LDG + u.pn * BM + wc * 32 + 8 * fq;
#pragma unroll
        for (int ai = 0; ai < 2; ++ai)
#pragma unroll
            for (int m = 0; m < 4; ++m)
#pragma unroll
                for (int bj = 0; bj < 2; ++bj) { const bf16_t* p = gp + (size_t)(ai * HALF + m * 16) * LDG + bj * HALF;
                    const u32x4 a = *(const u32x4*)p, b = *(const u32x4*)(p + DM);
                    acc[ai][bj][m][0][0] *= bflo(a.x) * __builtin_amdgcn_rcpf(bflo(b.x)); acc[ai][bj][m][0][1] *= bfhi(a.x) * __builtin_amdgcn_rcpf(bfhi(b.x));
                    acc[ai][bj][m][0][2] *= bflo(a.y) * __builtin_amdgcn_rcpf(bflo(b.y)); acc[ai][bj][m][0][3] *= bfhi(a.y) * __builtin_amdgcn_rcpf(bfhi(b.y));
                    acc[ai][bj][m][1][0] *= bflo(a.z) * __builtin_amdgcn_rcpf(bflo(b.z)); acc[ai][bj][m][1][1] *= bfhi(a.z) * __builtin_amdgcn_rcpf(bfhi(b.z));
                    acc[ai][bj][m][1][2] *= bflo(a.w) * __builtin_amdgcn_rcpf(bflo(b.w)); acc[ai][bj][m][1][3] *= bfhi(a.w) * __builtin_amdgcn_rcpf(bfhi(b.w));
                    __builtin_amdgcn_sched_barrier(0); }
    }
    __device__ __forceinline__ void operator()(const f32x4 (&acc)[2][2][4][2], const Unit& u, int wr, int wc, int fr, int fq) const {
        const int row0 = u.pm * BM + wr * 64 + fr, col0 = u.pn * BM + wc * 32 + 8 * fq;
        const bf16_t* gp = gb + (size_t)row0 * LDG + DM + col0;
        constexpr float F = SC_M / (SC_Y * SC_WB);
#pragma unroll
        for (int ai = 0; ai < 2; ++ai)
#pragma unroll
            for (int m = 0; m < 4; ++m)
#pragma unroll
                for (int bj = 0; bj < 2; ++bj) { const u32x4 b = *(const u32x4*)(gp + (size_t)(ai * HALF + m * 16) * LDG + bj * HALF);
                    const f32x4 v0 = acc[ai][bj][m][0] * F, v1 = acc[ai][bj][m][1] * F;
                    u32x2 w; w.x = pk4_fp8(v0[0] * bflo(b.x), v0[1] * bfhi(b.x), v0[2] * bflo(b.y), v0[3] * bfhi(b.y));
                    w.y = pk4_fp8(v1[0] * bflo(b.z), v1[1] * bfhi(b.z), v1[2] * bflo(b.w), v1[3] * bfhi(b.w));
                    *(u32x2*)((unsigned char*)O + (size_t)(row0 + ai * HALF + m * 16) * DM + col0 + bj * HALF) = w; }
    }
};
struct EpiOut {
    static constexpr bool PERM = true;
    bf16_t* O;
    __device__ __forceinline__ void operator()(const f32x4 (&acc)[2][2][4][2], const Unit& u, int wr, int wc, int fr, int fq) const {
        const int row0 = u.pm * BM + wr * 64 + fr, col0 = u.pn * BM + wc * 32 + 8 * fq;
#pragma unroll
        for (int ai = 0; ai < 2; ++ai)
#pragma unroll
            for (int m = 0; m < 4; ++m) { bf16_t* rowp = O + (size_t)(row0 + ai * HALF + m * 16) * DM + col0;
#pragma unroll
                for (int bj = 0; bj < 2; ++bj) { constexpr float F = 1.f / (SC_M * SC_WO); const f32x4 v0 = acc[ai][bj][m][0] * F, v1 = acc[ai][bj][m][1] * F;
                    u32x4 w; w.x = cvt_pk_bf16(v0[0], v0[1]); w.y = cvt_pk_bf16(v0[2], v0[3]); w.z = cvt_pk_bf16(v1[0], v1[1]); w.w = cvt_pk_bf16(v1[2], v1[3]);
                    *(u32x4*)(rowp + bj * HALF) = w; } }
    }
};
}

struct TrDesc { const float* src; size_t ld_src; bf16_t* dst; size_t ld_dst; float f8scale; };
constexpr int TR_A = 32 * 256, TR_B = 32 * 128, TR_C = 2 * 16 * 64, TR_D = 32 * 64, TR_T = TR_A + TR_B + TR_C + TR_D;
__device__ __forceinline__ TrDesc tr_desc(const Params& P, int t) {
    TrDesc d;
    if (t < TR_A) { const int kt = t & 31, nt = t >> 5, c = nt * 64, r = c >> 11, within = c & 2047;
        d.src = P.w_in + (size_t)(kt * 128) * INCOLS + c; d.ld_src = INCOLS; d.ld_dst = DM;
        if (r >= 2) { d.dst = (bf16_t*)(P.WinT8 + (size_t)((r - 2) * 2048 + within) * DM + kt * 128); d.f8scale = SC_W1; }
        else { d.dst = P.WinT + (size_t)(r * 2048 + within) * DM + kt * 128; d.f8scale = 0.f; } }
    else if (t < TR_A + TR_B) { const int u = t - TR_A, kt = u & 31, nt = u >> 5; d.src = P.w_in + (size_t)(kt * 128) * INCOLS + 16400 + nt * 64; d.ld_src = INCOLS;
        d.dst = (bf16_t*)(P.WinT8 + (size_t)(12288 + nt * 64) * DM + kt * 128); d.ld_dst = DM; d.f8scale = SC_W1; }
    else if (t < TR_A + TR_B + TR_C) { const int u = t - TR_A - TR_B, br = u >> 10, v = u & 1023, kt = v & 15, nt = v >> 4;
        d.src = P.w_branch + (size_t)br * 2048 * DM + (size_t)(kt * 128) * DM + nt * 64; d.ld_src = DM; d.dst = (bf16_t*)((unsigned char*)P.WbrT + (size_t)(nt * 64) * DM + br * 2048 + kt * 128); d.ld_dst = DM; d.f8scale = SC_WB; }
    else { const int u = t - TR_A - TR_B - TR_C, kt = u & 31, nt = u >> 5; d.src = P.w_out + (size_t)(kt * 128) * DM + nt * 64; d.ld_src = DM; d.dst = (bf16_t*)((unsigned char*)P.WoutT + (size_t)(nt * 64) * DM + kt * 128); d.ld_dst = DM; d.f8scale = SC_WO; }
    return d;
}
__device__ void phase_prologue(const Params& P, char* lds) {
    const int tid = threadIdx.x, lane = tid & 63, wid = tid >> 6;
    for (int i = blockIdx.x * 512 + tid; i < 1024 * 128 / 4; i += gridDim.x * 512) *(f32x4*)(P.kmean + (size_t)i * 4) = (f32x4){0.f, 0.f, 0.f, 0.f};
    constexpr int PW = 8208;
    for (int k = tid; k < DM; k += 512) { const float* wp = P.w_in + (size_t)k * INCOLS + 16384;
        const f32x4 w0 = *(const f32x4*)wp, w1 = *(const f32x4*)(wp + 4), w2 = *(const f32x4*)(wp + 8), w3 = *(const f32x4*)(wp + 12);
        const float wv[16] = {w0[0], w0[1], w0[2], w0[3], w1[0], w1[1], w1[2], w1[3], w2[0], w2[1], w2[2], w2[3], w3[0], w3[1], w3[2], w3[3]};
#pragma unroll
        for (int n = 0; n < 16; ++n) *(bf16_t*)(lds + n * PW + k * 2) = (bf16_t)cvt_pk_bf16(wv[n], 0.f); }
    __syncthreads();
    f32x4* comb = (f32x4*)(lds + 16 * PW);
    { const int tb = wid & 3, kh = wid >> 2, r = lane & 15, kq = lane >> 4;
      for (int rt0 = blockIdx.x * 4; rt0 < NTOK / 16; rt0 += gridDim.x * 4) {
          const int rt = rt0 + tb; f32x4 acc = {0.f, 0.f, 0.f, 0.f};
          const float* xp = P.x + (size_t)(rt * 16 + r) * DM + kh * 2048 + kq * 8; bf16_t* xo = P.xb + (size_t)(rt * 16 + r) * DM + kh * 2048 + kq * 8; unsigned char* x8o = P.x8 + (size_t)(rt * 16 + r) * DM + kh * 2048 + kq * 8;
          const char* wl = lds + r * PW + (kh * 2048 + kq * 8) * 2;
#pragma unroll 4
          for (int ks = 0; ks < 64; ++ks) { const f32x4 a0 = *(const f32x4*)(xp + ks * 32), a1 = *(const f32x4*)(xp + ks * 32 + 4);
              u32x4 w = {cvt_pk_bf16(a0[0], a0[1]), cvt_pk_bf16(a0[2], a0[3]), cvt_pk_bf16(a1[0], a1[1]), cvt_pk_bf16(a1[2], a1[3])};
              *(u32x4*)(xo + ks * 32) = w;
              { u32x2 w8 = {pk4_fp8(a0[0], a0[1], a0[2], a0[3]), pk4_fp8(a1[0], a1[1], a1[2], a1[3])}; *(u32x2*)(x8o + ks * 32) = w8; }
              const bf16x8 bfr = *(const bf16x8*)(wl + ks * 64);
              acc = __builtin_amdgcn_mfma_f32_16x16x32_bf16(*reinterpret_cast<bf16x8*>(&w), bfr, acc, 0, 0, 0); }
          if (kh == 1) comb[tb * 64 + lane] = acc;
          __syncthreads();
          if (kh == 0) { acc += comb[tb * 64 + lane]; const int s0 = rt * 16, bb = s0 >> 12, sl = s0 & 4095;
              *(f32x4*)(P.flogT + (size_t)(bb * NH + r) * SEQ + sl + kq * 4) = acc; }
          __syncthreads();
      } }
    constexpr int PB = 264;
    const int nq = tid & 15, kb = tid >> 4;
#define TR_LOAD(R, tt) do { if ((tt) < TR_T) { const TrDesc dl_ = tr_desc(P, (tt)); const float* sp = dl_.src + (size_t)(kb * 4) * dl_.ld_src + nq * 4; \
        R##0 = *(const f32x4*)sp; R##1 = *(const f32x4*)(sp + dl_.ld_src); R##2 = *(const f32x4*)(sp + 2 * dl_.ld_src); R##3 = *(const f32x4*)(sp + 3 * dl_.ld_src); } } while (0)
#define TR_BODY(R, tt, lb) do { const TrDesc d = tr_desc(P, (tt)); const bool f8 = d.f8scale != 0.f; char* lb_ = (lb);                  \
        if (!f8) { _Pragma("unroll") for (int i = 0; i < 4; ++i) { u32x2 w; w.x = cvt_pk_bf16(R##0[i], R##1[i]); w.y = cvt_pk_bf16(R##2[i], R##3[i]); *(u32x2*)(lb_ + (nq * 4 + i) * PB + kb * 8) = w; } } \
        else { const float sc = d.f8scale; _Pragma("unroll") for (int i = 0; i < 4; ++i) *(unsigned*)(lb_ + (nq * 4 + i) * 144 + kb * 4) = pk4_fp8(R##0[i] * sc, R##1[i] * sc, R##2[i] * sc, R##3[i] * sc); } \
        __syncthreads();                                                                                                                  \
        TR_LOAD(R, (tt) + 2 * G);                                                                                                         \
        if (!f8) { _Pragma("unroll") for (int i = 0; i < 2; ++i) { const int id = tid + i * 512, n = id >> 4, c = id & 15;                 \
                const u32x2 a = *(const u32x2*)(lb_ + n * PB + c * 16), b2 = *(const u32x2*)(lb_ + n * PB + c * 16 + 8);                   \
                u32x4 w = {a.x, a.y, b2.x, b2.y}; *(u32x4*)(d.dst + (size_t)n * d.ld_dst + c * 8) = w; } }                                \
        else { const int n = tid >> 3, c = tid & 7; *(u32x4*)((unsigned char*)d.dst + (size_t)n * d.ld_dst + c * 16) = *(const u32x4*)(lb_ + n * 144 + c * 16); } } while (0)
    const int G = (int)gridDim.x; int t = blockIdx.x;
    f32x4 ra0, ra1, ra2, ra3, rb0, rb1, rb2, rb3;
    TR_LOAD(ra, t); TR_LOAD(rb, t + G);
    while (t < TR_T) {
        TR_BODY(ra, t, lds); t += G; if (t >= TR_T) break;
        TR_BODY(rb, t, lds + 17408); t += G;
    }
#undef TR_LOAD
#undef TR_BODY
}

__device__ void phase_stats(const Params& P, char* lds) {
    const int tid = threadIdx.x;
    float* red = (float*)lds;
    for (int id = blockIdx.x; id < 1024; id += gridDim.x) {
        const int n = id & 15, h = (id >> 4) & 15, b = id >> 8;
        const int rg = tid >> 4, ch = tid & 15;
        float a[8] = {0, 0, 0, 0, 0, 0, 0, 0};
#pragma unroll
        for (int i = 0; i < 8; ++i) { const u32x4 w = *(const u32x4*)(P.hm + 1 * HM_REG + ((size_t)(b * NH + h) * SEQ + n * 256 + rg + 32 * i) * 128 + ch * 8);
            a[0] += bflo(w.x); a[1] += bfhi(w.x); a[2] += bflo(w.y); a[3] += bfhi(w.y); a[4] += bflo(w.z); a[5] += bfhi(w.z); a[6] += bflo(w.w); a[7] += bfhi(w.w); }
#pragma unroll
        for (int j = 0; j < 8; ++j) red[rg * 128 + ch * 8 + j] = a[j];
        __syncthreads();
        if (tid < 128) { float sm = 0.f; for (int r = 0; r < 32; ++r) sm += red[r * 128 + tid]; P.kmean[(size_t)id * 128 + tid] = sm * (1.f / 256.f); }
        __syncthreads();
    }
}

constexpr int SHM_K = 16384, SHM_V = 16384;
#define KSWZ(row, colB) ((row) * 256 + ((colB) ^ (((row) & 7) << 4)))
#define SBAR() __builtin_amdgcn_sched_barrier(0)
__device__ __forceinline__ int v_st(int k, int c) { const int kk = (k & ~0xC) | ((k & 4) << 1) | ((k & 8) >> 1); return ((kk >> 3) * 4 + (c >> 5)) * 512 + ((kk & 7) * 32 + (c & 31)) * 2; }
__device__ __forceinline__ int v_rd_base(int lane) { return ((lane & 3) << 3) | (((lane >> 2) & 3) << 6) | (((lane >> 4) & 1) << 5) | (((lane >> 5) & 1) << 8); }
constexpr int v_rd_off(int d0, int ks, int half) { return d0 * 512 + ks * 4096 + half * 2048; }
__device__ __forceinline__ int crow(int r, int hi) { return (r & 3) + 8 * (r >> 2) + 4 * hi; }

template <int KB>
__device__ __forceinline__ void qkt(f32x16& p0, f32x16& p1, const char* K_lds, int r32, int hi, const bf16x8* qr) {
    const char* kb[4];
#pragma unroll
    for (int dd = 0; dd < 4; ++dd) kb[dd] = K_lds + KB * SHM_K + KSWZ(r32, (dd * 16 + hi * 8) * 2);
#pragma unroll
    for (int d0 = 0; d0 < 8; ++d0) { const char* a = kb[d0 & 3] + (d0 >> 2) * 128;
        bf16x8 b0 = *reinterpret_cast<const bf16x8*>(a);
        bf16x8 b1 = *reinterpret_cast<const bf16x8*>(a + 32 * 256);
        p0 = __builtin_amdgcn_mfma_f32_32x32x16_bf16(b0, qr[d0], p0, 0, 0, 0);
        p1 = __builtin_amdgcn_mfma_f32_32x32x16_bf16(b1, qr[d0], p1, 0, 0, 0); }
}
template <int VB>
__device__ __forceinline__ void pv_tile(f32x16* o, int vb0, bf16x8 pa0, bf16x8 pa1, bf16x8 pa2, bf16x8 pa3) {
#define TRRD(dst, off) asm volatile("ds_read_b64_tr_b16 %0, %1 offset:%2" : "=&v"(dst) : "v"(vb0), "i"(off) : "memory")
#define PV_D0(d0) do { s16x4 l0, l1, l2, l3, h0, h1, h2, h3; constexpr int b_ = VB * SHM_V + v_rd_off(d0, 0, 0); \
        TRRD(l0, b_); TRRD(h0, b_ + 2048); TRRD(l1, b_ + 4096); TRRD(h1, b_ + 6144); TRRD(l2, b_ + 8192); TRRD(h2, b_ + 10240); TRRD(l3, b_ + 12288); TRRD(h3, b_ + 14336); \
        asm volatile("s_waitcnt lgkmcnt(0)" ::: "memory"); SBAR(); \
        o[d0] = __builtin_amdgcn_mfma_f32_32x32x16_bf16(pa0, (bf16x8){l0[0], l0[1], l0[2], l0[3], h0[0], h0[1], h0[2], h0[3]}, o[d0], 0, 0, 0);   \
        o[d0] = __builtin_amdgcn_mfma_f32_32x32x16_bf16(pa1, (bf16x8){l1[0], l1[1], l1[2], l1[3], h1[0], h1[1], h1[2], h1[3]}, o[d0], 0, 0, 0);   \
        o[d0] = __builtin_amdgcn_mfma_f32_32x32x16_bf16(pa2, (bf16x8){l2[0], l2[1], l2[2], l2[3], h2[0], h2[1], h2[2], h2[3]}, o[d0], 0, 0, 0);   \
        o[d0] = __builtin_amdgcn_mfma_f32_32x32x16_bf16(pa3, (bf16x8){l3[0], l3[1], l3[2], l3[3], h3[0], h3[1], h3[2], h3[3]}, o[d0], 0, 0, 0); } while (0)
    PV_D0(0); PV_D0(1); PV_D0(2); PV_D0(3);
#undef PV_D0
#undef TRRD
}
typedef __bf16 bf16x2_t __attribute__((ext_vector_type(2)));
__device__ __forceinline__ unsigned pk2(float lo, float hi) { f32x2 v = {lo, hi}; bf16x2_t b = __builtin_convertvector(v, bf16x2_t); return *reinterpret_cast<unsigned*>(&b); }
__device__ __forceinline__ void softmax_tile(f32x16& p0, f32x16& p1, float tc, float& m_reg, float& l_reg, float& alpha, bf16x8& pa0, bf16x8& pa1, bf16x8& pa2, bf16x8& pa3) {
    float pmax = p0[0];
#pragma unroll
    for (int r = 1; r < 16; ++r) pmax = fmaxf(pmax, p0[r]);
#pragma unroll
    for (int r = 0; r < 16; ++r) pmax = fmaxf(pmax, p1[r]);
    { auto rr = __builtin_amdgcn_permlane32_swap(__float_as_uint(pmax), __float_as_uint(pmax), false, false);
      pmax = fmaxf(__uint_as_float(rr[0]), __uint_as_float(rr[1])); }
    constexpr float C2s = LOG2E * ATT_SCALE;
    const float smax = fmaf(pmax, C2s, tc);
    const bool keep = __all(smax - m_reg <= 11.5f);
    const float mn = keep ? m_reg : fmaxf(m_reg, smax);
    alpha = __builtin_amdgcn_exp2f(m_reg - mn); m_reg = mn;
    const float mnl = tc - mn;
#pragma unroll
    for (int r = 0; r < 16; ++r) p0[r] = __builtin_amdgcn_exp2f(fmaf(p0[r], C2s, mnl));
#pragma unroll
    for (int r = 0; r < 16; ++r) p1[r] = __builtin_amdgcn_exp2f(fmaf(p1[r], C2s, mnl));
    float ps = 0;
#pragma unroll
    for (int r = 0; r < 16; ++r) ps += p0[r];
#pragma unroll
    for (int r = 0; r < 16; ++r) ps += p1[r];
    { auto rr = __builtin_amdgcn_permlane32_swap(__float_as_uint(ps), __float_as_uint(ps), false, false);
      ps = __uint_as_float(rr[0]) + __uint_as_float(rr[1]); }
    l_reg = l_reg * alpha + ps;
#define PK4(P, B_, OUT) do { unsigned a0 = pk2(P[B_+0], P[B_+1]), a1 = pk2(P[B_+2], P[B_+3]);                          \
        unsigned b0 = pk2(P[B_+4], P[B_+5]), b1 = pk2(P[B_+6], P[B_+7]);                                             \
        auto r0 = __builtin_amdgcn_permlane32_swap(a0, b0, false, false); auto r1 = __builtin_amdgcn_permlane32_swap(a1, b1, false, false); \
        u32x4 w = {r0[0], r1[0], r0[1], r1[1]}; OUT = *reinterpret_cast<bf16x8*>(&w); } while (0)
    PK4(p0, 0, pa0); PK4(p0, 8, pa1); PK4(p1, 0, pa2); PK4(p1, 8, pa3);
#undef PK4
}
__device__ __forceinline__ int t5_bucket(int d) {
    if (d < 16) return d;
    const float v = logf((float)d * (1.f / 16.f)) / 2.0794415416798357f * 16.f;
    const int l = 16 + (int)v; return l < 31 ? l : 31;
}

template <int TYPE>
__device__ __forceinline__ void attn_block(const Params& P, char* lds, int b, int h, int qb) {
    int tid_ = threadIdx.x; asm volatile("" : "+v"(tid_));
    const int tid = tid_, wid = __builtin_amdgcn_readfirstlane(tid >> 6), lane = tid & 63, r32 = lane & 31, hi = lane >> 5;
    const size_t tok0 = (size_t)b * SEQ, hs0 = (size_t)(b * NH + h) * SEQ * 128;
    const bf16_t* Qp = P.hm + (TYPE * 4 + 0) * HM_REG + hs0 + (size_t)qb * 256 * 128;
    const bf16_t* Kp = P.hm + (TYPE * 4 + 1) * HM_REG + hs0;
    const bf16_t* Vp = P.hm + (TYPE * 4 + 2) * HM_REG + hs0;
    const bf16_t* Zp = P.hm + (TYPE * 4 + 3) * HM_REG + hs0 + (size_t)qb * 256 * 128;
    unsigned char* Yp = (unsigned char*)P.Y + (tok0 + qb * 256) * DM + TYPE * 2048 + h * 128;
    char* V_lds = lds; char* K_lds = lds + 3 * SHM_V;
    float* ws = (float*)(lds + 98304) + wid * 64; float* li_l = ws; float* al_l = ws + 32;
    float* cbuf = (float*)(lds + 98304 + 2048); float* relb = cbuf + 4096;
    const int NT = (qb + 1) * 4;
    const int qlo = qb * 256 + wid * 32, qpos = qlo + r32;
    constexpr float C2 = LOG2E * ATT_SCALE;
    const float NEG = -__builtin_inff();

    bf16x8 qr[8];
#pragma unroll
    for (int d0 = 0; d0 < 8; ++d0) qr[d0] = *(const bf16x8*)(Qp + (size_t)(wid * 32 + r32) * 128 + d0 * 16 + hi * 8);

    unsigned sel = 0; float b31 = 0.f;
    if constexpr (TYPE == 0) {
        if (tid < 128) cbuf[tid] = P.rel_bias[t5_bucket(tid) * NH + h] * (1.f / ATT_SCALE);
        { const int row = tid >> 4, ch = tid & 15, n = row & 15;
          const float* km = P.kmean + ((size_t)((b * NH + h) * 16 + n)) * 128 + ch * 8;
          const f32x4 a = *(const f32x4*)km, c = *(const f32x4*)(km + 4);
          float v[8] = {a[0], a[1], a[2], a[3], c[0], c[1], c[2], c[3]};
          if (row >= 16) {
#pragma unroll
              for (int j = 0; j < 8; ++j) { const float hf = __uint_as_float(cvt_pk_bf16(v[j], 0.f) << 16); v[j] = v[j] - hf; } }
          u32x4 w = {cvt_pk_bf16(v[0], v[1]), cvt_pk_bf16(v[2], v[3]), cvt_pk_bf16(v[4], v[5]), cvt_pk_bf16(v[6], v[7])};
          *(u32x4*)(K_lds + KSWZ(row, ch * 16)) = w; }
        __syncthreads();
        f32x16 g = f32x16{};
        { const char* kb[4];
#pragma unroll
          for (int dd = 0; dd < 4; ++dd) kb[dd] = K_lds + KSWZ(r32, (dd * 16 + hi * 8) * 2);
#pragma unroll
          for (int d0 = 0; d0 < 8; ++d0) { const bf16x8 a = *reinterpret_cast<const bf16x8*>(kb[d0 & 3] + (d0 >> 2) * 128);
              g = __builtin_amdgcn_mfma_f32_32x32x16_bf16(a, qr[d0], g, 0, 0, 0); } }
        float ga[16];
#pragma unroll
        for (int r = 0; r < 8; ++r) { const float mine = g[r] + g[r + 8]; const float oth = __shfl_xor(mine, 32);
            const int nb = (r & 3) + 8 * (r >> 2); ga[nb] = hi ? oth : mine; ga[nb + 4] = hi ? mine : oth; }
#pragma unroll
        for (int pass = 0; pass < 3; ++pass) { float best = NEG; int bi = -1;
#pragma unroll
            for (int n = 0; n < 16; ++n) { const bool ok = (n < qb) && !((sel >> n) & 1u) && (ga[n] > best); best = ok ? ga[n] : best; bi = ok ? n : bi; }
            if (bi >= 0) sel |= 1u << bi; }
        b31 = cbuf[127];
        __syncthreads();
    } else {
        const float* fl = P.flogT + (size_t)(b * NH + h) * SEQ; const float bfg = P.b_forget[h];
        float* sred = (float*)(lds + 98304 + 2048 + 32768);
        const bool in = tid * 8 < (qb + 1) * 256;
        float v[8]; float run = 0.f;
        if (in) { const f32x4 a = *(const f32x4*)(fl + tid * 8), c = *(const f32x4*)(fl + tid * 8 + 4);
            const float zz[8] = {a[0], a[1], a[2], a[3], c[0], c[1], c[2], c[3]};
#pragma unroll
            for (int i = 0; i < 8; ++i) { const float z = zz[i] + bfg; run += fminf(z, 0.f) - log1pf(expf(-fabsf(z))); v[i] = run; } }
        float inc = run;
#pragma unroll
        for (int off = 1; off < 64; off <<= 1) { const float ov = __shfl_up(inc, off); if (lane >= off) inc += ov; }
        if (lane == 63) sred[wid] = inc;
        __syncthreads();
        float base = inc - run;
        for (int w = 0; w < wid; ++w) base += sred[w];
        if (in) { *(f32x4*)(cbuf + tid * 8) = (f32x4){-(base + v[0]), -(base + v[1]), -(base + v[2]), -(base + v[3])};
                  *(f32x4*)(cbuf + tid * 8 + 4) = (f32x4){-(base + v[4]), -(base + v[5]), -(base + v[6]), -(base + v[7])}; }
        __syncthreads();
        constexpr float RS = 1.f / ATT_SCALE;
        if (in) { const float ref = cbuf[(tid * 8) & ~63];
            const f32x4 a = *(const f32x4*)(cbuf + tid * 8), c = *(const f32x4*)(cbuf + tid * 8 + 4);
            *(f32x4*)(relb + tid * 8) = (a - ref) * RS; *(f32x4*)(relb + tid * 8 + 4) = (c - ref) * RS; }
    }

    float m_reg = -1e30f, l_reg = 0.f; f32x16 o[4] = {};
    const int sr = tid >> 4, sc = (tid & 15) * 8, vst0 = v_st(sr, sc), vst1 = v_st(32 + sr, sc), kws = KSWZ(sr, sc * 2);
    const int vb0 = (int)(uintptr_t)V_lds + v_rd_base(lane);
    LAS unsigned char* ldsa = (LAS unsigned char*)(unsigned)(uintptr_t)lds;
    const int dk_row = wid * 4 + (lane >> 4), dk_col = ((((lane & 15) * 16) ^ ((dk_row & 7) << 4)) >> 1);
    const bf16_t* kg0 = Kp + (size_t)dk_row * 128 + dk_col;
    const int kkv = (wid >> 1) * 8 + ((lane & 31) >> 2), dv_k = (kkv & ~0xC) | ((kkv & 4) << 1) | ((kkv & 8) >> 1), dv_c = ((wid & 1) * 2 + (lane >> 5)) * 32 + (lane & 3) * 8;
    const bf16_t* vg0 = Vp + (size_t)dv_k * 128 + dv_c;
#define DMAK(k0, bf) do { _Pragma("unroll") for (int _i = 0; _i < 2; ++_i) __builtin_amdgcn_global_load_lds((const unsigned*)(kg0 + (size_t)((k0) + _i * 32) * 128), \
        (LAS unsigned*)(ldsa + 3 * SHM_V + (bf) * SHM_K + _i * 8192 + wid * 1024), 16, 0, 0); } while (0)
#define DMAV(k0, bf) do { _Pragma("unroll") for (int _i = 0; _i < 2; ++_i) __builtin_amdgcn_global_load_lds((const unsigned*)(vg0 + (size_t)((k0) + _i * 32) * 128), \
        (LAS unsigned*)(ldsa + (bf) * SHM_V + _i * 8192 + wid * 1024), 16, 0, 0); } while (0)
#define VMW() asm volatile("s_waitcnt vmcnt(0)" ::: "memory")
#define SGB(mask, n) __builtin_amdgcn_sched_group_barrier(mask, n, 0)
#define INITP(P0, P1, kq_, GEN) do {                                                                                                     \
        if constexpr (TYPE == 1) { const f32x4* cb = (const f32x4*)(relb + (kq_) + 4 * hi);                                               \
            _Pragma("unroll") for (int q = 0; q < 4; ++q) { const f32x4 c0 = cb[2 * q], c1 = cb[2 * q + 8];                               \
                _Pragma("unroll") for (int i = 0; i < 4; ++i) { P0[4 * q + i] = c0[i]; P1[4 * q + i] = c1[i]; } }                         \
        } else { P0 = f32x16{}; P1 = f32x16{}; } } while (0)
#define ADDB(P0, P1, kq_, GEN) do {                                                                                                      \
        if constexpr (TYPE == 1) {                                                                                                        \
        } else { const int nblk = (kq_) >> 8; const bool okl = (nblk == qb) || ((sel >> nblk) & 1u);                                     \
            if (GEN && ((kq_) + 191 > qlo)) {                                                                                             \
                _Pragma("unroll") for (int r = 0; r < 16; ++r) { const int d = qpos - (kq_) - crow(r, hi);                                \
                    const float t0 = cbuf[min(max(d, 0), 127)], t1 = cbuf[min(max(d - 32, 0), 127)];                                      \
                    P0[r] = (okl && d >= 0) ? P0[r] + t0 : NEG; P1[r] = (okl && d >= 32) ? P1[r] + t1 : NEG; }                            \
            } else { const float bl = okl ? b31 : NEG;                                                                                    \
                _Pragma("unroll") for (int r = 0; r < 16; ++r) { P0[r] += bl; P1[r] += bl; } } } } while (0)
#define STEP(t, PC0, PC1, PN0, PN1, INT) do { const int kb_ = (t) * 64; const bool moreK = INT || ((t) + 3 < NT), moreV = INT || ((t) + 2 < NT);  \
        const int i1 = (i0 == 2) ? 0 : i0 + 1, i2 = (i1 == 2) ? 0 : i1 + 1;                                                               \
        if (moreK) DMAK(kb_ + 192, i0); if (moreV) DMAV(kb_ + 128, i2);                                                                   \
        SBAR();                                                                                                                           \
        if (INT || (((t) + 1 < NT) && (kb_ + 64 <= qlo + 31))) { INITP(PN0, PN1, kb_ + 64, !(INT)); qkt<0>(PN0, PN1, K_lds + i1 * SHM_K, r32, hi, qr); } \
        if (INT || (kb_ <= qlo + 31)) {                                                                                                   \
            if constexpr (TYPE == 1) { if (!INT && (kb_ + 63 > qlo)) {                                                                    \
                    _Pragma("unroll") for (int r = 0; r < 16; ++r) { const int key = kb_ + crow(r, hi);                                   \
                        if (key > qpos) PC0[r] = NEG; if (key + 32 > qpos) PC1[r] = NEG; } } }                                            \
            ADDB(PC0, PC1, kb_, !(INT));                                                                                                  \
            float alpha; bf16x8 pa0, pa1, pa2, pa3;                                                                                       \
            const float tc_ = TYPE ? cbuf[kb_] * LOG2E : 0.f;                                                                             \
            softmax_tile(PC0, PC1, tc_, m_reg, l_reg, alpha, pa0, pa1, pa2, pa3);                                                              \
            \
            SBAR();                                                                                                                       \
            if (__any(alpha < 1.f)) { if (hi == 0) al_l[r32] = alpha; asm volatile("s_waitcnt lgkmcnt(0)" ::: "memory");                  \
                _Pragma("unroll") for (int d_ = 0; d_ < 4; ++d_) _Pragma("unroll") for (int r = 0; r < 16; ++r) o[d_][r] *= al_l[crow(r, hi)]; } \
            SBAR(); pv_tile<0>(o, vb0 + i0 * SHM_V, pa0, pa1, pa2, pa3);                                                                  \
        }                                                                                                                                 \
        if (moreK) asm volatile("s_waitcnt vmcnt(4) lgkmcnt(0)" ::: "memory"); else asm volatile("s_waitcnt vmcnt(0) lgkmcnt(0)" ::: "memory"); \
        __builtin_amdgcn_s_barrier(); asm volatile("" ::: "memory"); i0 = i1; } while (0)

    DMAK(0, 0); DMAV(0, 0); DMAK(64, 1); DMAK(128, 2); DMAV(64, 1);
    asm volatile("s_waitcnt vmcnt(4) lgkmcnt(0)" ::: "memory");
    __builtin_amdgcn_s_barrier(); asm volatile("" ::: "memory");
    f32x16 pA0, pA1, pB0, pB1; int i0 = 0;
    INITP(pA0, pA1, 0, true); qkt<0>(pA0, pA1, K_lds, r32, hi, qr);
    const int NI = TYPE ? 4 * qb : (qb > 0 ? 4 * qb - 4 : 0);
    int j = 0;
    for (; j < NI; j += 2) { STEP(j, pA0, pA1, pB0, pB1, 1); STEP(j + 1, pB0, pB1, pA0, pA1, 1); }
    for (; j < NT; j += 2) { STEP(j, pA0, pA1, pB0, pB1, 0); STEP(j + 1, pB0, pB1, pA0, pA1, 0); }
#undef SGB
#undef INITP
#undef ADDB
#undef STEP
#undef DMAK
#undef DMAV
#undef VMW
#undef ROWP
    if (hi == 0) li_l[r32] = l_reg;
    asm volatile("s_waitcnt lgkmcnt(0)" ::: "memory");
#pragma unroll
    for (int r = 0; r < 16; ++r) { const int orow = wid * 32 + crow(r, hi); const float rl = __builtin_amdgcn_rcpf(li_l[crow(r, hi)]);
#pragma unroll
        for (int d0 = 0; d0 < 4; ++d0) { const float z = bf2f(Zp[(size_t)orow * 128 + d0 * 32 + r32]);
            const float v = o[d0][r] * rl * z * __builtin_amdgcn_rcpf(1.f + __builtin_amdgcn_exp2f(-LOG2E * z));
            const float vn = __shfl_xor(v, 1);
            const int pk = __builtin_amdgcn_cvt_pk_fp8_f32(v * SC_Y, vn * SC_Y, 0, false);
            const int pq = __shfl_xor(pk, 2);
            if ((r32 & 3) == 0) *(unsigned*)(Yp + (size_t)orow * DM + d0 * 32 + r32) = ((unsigned)pk & 0xffffu) | ((unsigned)pq << 16); } }
    __syncthreads();
}
__device__ void phase_attention(const Params& P, char* lds) {
    const int c = blockIdx.x, xcd = c & 7, s = c >> 3;
    const int nslot = (int)(gridDim.x >> 3);
    for (int i2 = 0; ; ++i2) {
        const int slot = s + (i2 >> 1) * nslot;
        if (slot >= 128) break;
        const int x = slot & 7, gidx = slot >> 3;
        const int type = gidx >> 3, bh = (gidx & 7) * 8 + xcd;
        const int b = bh >> 4, h = bh & 15, qb = (i2 & 1) ? x : 15 - x;
        if (type == 0) attn_block<0>(P, lds, b, h, qb);
        else           attn_block<1>(P, lds, b, h, qb);
    }
}

__device__ void phase_ln(const Params& P) {
    const int lane = threadIdx.x & 63, gw = blockIdx.x * 8 + (threadIdx.x >> 6), nw = gridDim.x * 8;
    for (int row = gw; row < NTOK; row += nw) {
        const float* xp = P.x + (size_t)row * DM; const bf16_t* op = P.outb + (size_t)row * DM; float* rp = P.out + (size_t)row * DM;
        f32x4 v[16]; float s = 0.f;
#pragma unroll
        for (int i = 0; i < 8; ++i) { const int c = (i * 64 + lane) * 8;
            const f32x4 x0 = *(const f32x4*)(xp + c), x1 = *(const f32x4*)(xp + c + 4); const u32x4 ob = *(const u32x4*)(op + c);
            v[2 * i] = x0 * DN_ALPHA + (f32x4){bflo(ob.x), bfhi(ob.x), bflo(ob.y), bfhi(ob.y)};
            v[2 * i + 1] = x1 * DN_ALPHA + (f32x4){bflo(ob.z), bfhi(ob.z), bflo(ob.w), bfhi(ob.w)};
            s += (v[2 * i][0] + v[2 * i][1]) + (v[2 * i][2] + v[2 * i][3]) + (v[2 * i + 1][0] + v[2 * i + 1][1]) + (v[2 * i + 1][2] + v[2 * i + 1][3]); }
#pragma unroll
        for (int off = 32; off > 0; off >>= 1) s += __shfl_xor(s, off);
        const float mu = s * (1.f / DM); float q = 0.f;
#pragma unroll
        for (int i = 0; i < 16; ++i) { const f32x4 d = v[i] - mu; q += (d[0] * d[0] + d[1] * d[1]) + (d[2] * d[2] + d[3] * d[3]); }
#pragma unroll
        for (int off = 32; off > 0; off >>= 1) q += __shfl_xor(q, off);
        const float rs = rsqrtf(q * (1.f / DM) + LN_EPS);
#pragma unroll
        for (int i = 0; i < 16; ++i) { const int c = ((i >> 1) * 64 + lane) * 8 + (i & 1) * 4; const f32x4 gn = *(const f32x4*)(P.ln_gain + c), bs = *(const f32x4*)(P.ln_bias + c);
            *(f32x4*)(rp + c) = (v[i] - mu) * rs * gn + bs; }
    }
}

#ifndef PHASE_MASK
#define PHASE_MASK 0x7f
#endif
__global__ void __launch_bounds__(512) fwd_megakernel(Params P) {
    extern __shared__ __attribute__((aligned(16))) unsigned char shm[];
    cg::grid_group grid = cg::this_grid();
    if (PHASE_MASK & 1) phase_prologue(P, (char*)shm);
    grid.sync();
    if (PHASE_MASK & 2) {
      { pg8::StaticOrder S; S.init(NTOK, 4096, (int)gridDim.x, (int)blockIdx.x);
        pg8::Gemm g{P.xb, P.WinT, NTOK, 4096, DM}; pg8::EpiProj E{P.hm, P.gbuf, P.b_gate, P.kmean, 0, 1.f};
        pg8::gemm_phase<pg8::EpiProj, false, false>((LAS unsigned char*)shm, g, S, E); }
      { pg8::StaticOrder S; S.init(NTOK, 20480, (int)gridDim.x, (int)blockIdx.x);
        pg8::Gemm g{(const bf16_t*)P.x8, (const bf16_t*)P.WinT8, NTOK, 20480, DM / 2}; pg8::EpiProj E{P.hm, P.gbuf, P.b_gate, P.kmean, 1, 1.f / SC_W1};
        pg8::gemm_phase<pg8::EpiProj, false, true>((LAS unsigned char*)shm, g, S, E); } }
    grid.sync();
    if (PHASE_MASK & 8) phase_attention(P, (char*)shm);
    grid.sync();
    if (PHASE_MASK & 16) { pg8::StaticOrder S; S.init(NTOK, DM, (int)gridDim.x, (int)blockIdx.x);
      pg8::Gemm g{P.Y, P.WbrT, NTOK, DM, DM / 2}; pg8::EpiMerged E{P.merged, P.gbuf};
      pg8::gemm_phase<pg8::EpiMerged, true, true>((LAS unsigned char*)shm, g, S, E); }
    grid.sync();
    if (PHASE_MASK & 32) { pg8::StaticOrder S; S.init(NTOK, DM, (int)gridDim.x, (int)blockIdx.x);
      pg8::Gemm g{P.merged, P.WoutT, NTOK, DM, DM / 2}; pg8::EpiOut E{P.outb};
      pg8::gemm_phase<pg8::EpiOut, false, true>((LAS unsigned char*)shm, g, S, E); }
    grid.sync();
    if (PHASE_MASK & 64) phase_ln(P);
}

extern "C" void kernel_launch(void* const* d_in, const int* in_sizes, int n_in, void* d_out, int out_size, void* d_ws, size_t ws_size, hipStream_t stream) {
    (void)in_sizes; (void)n_in; (void)out_size;
    static int grid_blocks = 0;
    if (!grid_blocks) {
        hipError_t e = hipFuncSetAttribute((const void*)fwd_megakernel, hipFuncAttributeMaxDynamicSharedMemorySize, LDS_BYTES);
        if (e != hipSuccess) fprintf(stderr, "hipFuncSetAttribute failed: %s\n", hipGetErrorString(e));
        int dev = 0, cus = 0, per_cu = 0;
        hipGetDevice(&dev);
        hipDeviceGetAttribute(&cus, hipDeviceAttributeMultiprocessorCount, dev);
        hipOccupancyMaxActiveBlocksPerMultiprocessor(&per_cu, fwd_megakernel, 512, LDS_BYTES);
        if (per_cu < 1) per_cu = 1;
        grid_blocks = cus;
        if (grid_blocks & 7) grid_blocks &= ~7;
    }
    Params p{};
    p.x = (const float*)d_in[0]; p.w_in = (const float*)d_in[1]; p.b_forget = (const float*)d_in[2]; p.b_gate = (const float*)d_in[3];
    p.rel_bias = (const float*)d_in[4]; p.w_branch = (const float*)d_in[5]; p.w_out = (const float*)d_in[6]; p.ln_gain = (const float*)d_in[7]; p.ln_bias = (const float*)d_in[8];
    p.out = (float*)d_out;
    char* w = (char*)d_ws; size_t off = 0;
    auto take = [&](size_t bytes) { char* r = w + off; off += (bytes + 255) & ~(size_t)255; return r; };
    p.xb = (bf16_t*)take((size_t)NTOK * DM * 2);
    p.merged = (bf16_t*)take((size_t)NTOK * DM * 2);
    p.outb = p.xb;
    p.x8 = (unsigned char*)p.merged + (size_t)NTOK * DM;
    p.WinT = (bf16_t*)take((size_t)LDP * DM * 2);
    p.WinT8 = (unsigned char*)p.WinT + (size_t)4096 * DM * 2;
    p.Y = (bf16_t*)take((size_t)NTOK * DM * 2);
    p.WbrT = (bf16_t*)take((size_t)DM * DM * 2);
    p.WoutT = (bf16_t*)take((size_t)DM * DM * 2);
    p.hm = (bf16_t*)take((size_t)8 * HM_REG * 2);
    p.gbuf = (bf16_t*)take((size_t)NTOK * LDG * 2);
    p.kmean = (float*)take((size_t)1024 * 128 * 4);
    p.flogT = (float*)take((size_t)64 * SEQ * 4);
    if (off > ws_size) { fprintf(stderr, "workspace too small: need %zu have %zu\n", off, ws_size); return; }
    void* args[] = {&p};
    hipError_t e = hipLaunchCooperativeKernel((const void*)fwd_megakernel, dim3(grid_blocks), dim3(512), args, LDS_BYTES, stream);
    if (e != hipSuccess) fprintf(stderr, "cooperative launch failed: %s (grid %d)\n", hipGetErrorString(e), grid_blocks);
}
```

```cpp
#include <hip/hip_runtime.h>
#include <hip/hip_cooperative_groups.h>
#include <cstdio>
#include <cstdint>
namespace cg = cooperative_groups;

#define LAS __attribute__((address_space(3)))
typedef unsigned short bf16_t;
typedef short bf16x8 __attribute__((ext_vector_type(8)));
typedef short s16x4 __attribute__((ext_vector_type(4)));
typedef float f32x2 __attribute__((ext_vector_type(2)));
typedef float f32x4 __attribute__((ext_vector_type(4)));
typedef float f32x16 __attribute__((ext_vector_type(16)));
typedef unsigned u32x2 __attribute__((ext_vector_type(2)));
typedef unsigned u32x4 __attribute__((ext_vector_type(4)));

constexpr int SEQ = 4096, DM = 4096, NTOK = 16384, NH = 16;
constexpr int INCOLS = 24592;
constexpr int LDP = 24576;
constexpr int COL_QA = 0, COL_KA = 2048, COL_VA = 4096, COL_ZA = 6144, COL_QF = 8192, COL_KF = 10240, COL_VF = 12288, COL_ZF = 14336,
              COL_G0 = 16384, COL_G1 = 20480;
constexpr float LOG2E = 1.4426950408889634f;
constexpr float ATT_SCALE = 0.08838834764831845f;
constexpr float DN_ALPHA = 1.189207115002721f;
constexpr float LN_EPS = 1e-5f;
constexpr int LDS_BYTES = 140 * 1024;
constexpr float SC_Y = 8.f, SC_WB = 64.f, SC_M = 64.f, SC_WO = 64.f, SC_W1 = 64.f;
constexpr size_t HM_REG = (size_t)NTOK * 2048;
constexpr int LDG = 8192;

struct Params {
    const float* x; const float* w_in; const float* b_forget; const float* b_gate; const float* rel_bias; const float* w_branch; const float* w_out;
    const float* ln_gain; const float* ln_bias;
    float* out;
    bf16_t* xb; bf16_t* WinT; bf16_t* WbrT; bf16_t* WoutT; bf16_t* hm; bf16_t* gbuf; bf16_t* Y; bf16_t* merged; bf16_t* outb; unsigned char* x8; unsigned char* WinT8;
    float* kmean; float* flogT;
};

__device__ __forceinline__ unsigned cvt_pk_bf16(float lo, float hi) { unsigned r; asm volatile("v_cvt_pk_bf16_f32 %0, %1, %2" : "=v"(r) : "v"(lo), "v"(hi)); return r; }
__device__ __forceinline__ unsigned pk4_fp8(float a, float b, float c, float d) { int w = __builtin_amdgcn_cvt_pk_fp8_f32(a, b, 0, false); w = __builtin_amdgcn_cvt_pk_fp8_f32(c, d, w, true); return (unsigned)w; }
__device__ __forceinline__ float bf2f(bf16_t b) { return __uint_as_float(((unsigned)b) << 16); }
__device__ __forceinline__ float bflo(unsigned w) { return __uint_as_float(w << 16); }
__device__ __forceinline__ float bfhi(unsigned w) { return __uint_as_float(w & 0xffff0000u); }

namespace pg8 {
constexpr int BM = 256, BK = 64, HALF = 128, HTB = HALF * BK * 2, STAGE_BYTES = 8 * HTB, NXCD = 8, WGM = 8;
__host__ __device__ __forceinline__ int lds_byte(int r, int c) { const int st = (r >> 4) * 2 + (c >> 5), rr = r & 15, cc = c & 31, ob = rr * 64 + cc * 2; return st * 1024 + (ob ^ (((ob >> 9) & 1) << 5)); }
__host__ __device__ __forceinline__ void stage_rc(int b, int& R, int& C) { const int st = b / 1024, sb = b % 1024, swz = sb ^ (((sb >> 9) & 1) << 5); R = (st >> 1) * 16 + swz / 64; C = (st & 1) * 32 + (swz % 64) / 2; }
__host__ __device__ __forceinline__ int perm32(int rho) { const int n = rho >> 4, i = rho & 15; return 8 * (i >> 2) + 4 * n + (i & 3); }
struct Unit { int pm, pn; };
struct Gemm { const bf16_t* A; const bf16_t* Bt; int M, N, K; };
struct StaticOrder {
    int nM, nN, nwg, G, c;
    __device__ void init(int M, int N, int G_, int c_) { nM = M / BM; nN = N / BM; nwg = nM * nN; G = G_; c = c_; }
    __device__ bool next(int i, Unit& u) const {
        const long L = (long)i * G + c; if (L >= nwg) return false;
        int wgid = (int)L; { const int q = nwg / NXCD, r = nwg % NXCD, xcd = wgid % NXCD, off = wgid / NXCD; wgid = (xcd < r ? xcd * (q + 1) : r * (q + 1) + (xcd - r) * q) + off; }
        const int nig = WGM * nN, gid = wgid / nig, fm = gid * WGM, gsz = (nM - fm) < WGM ? (nM - fm) : WGM;
        u.pm = fm + ((wgid % nig) % gsz); u.pn = (wgid % nig) / gsz; return true;
    }
};

typedef int i32x8 __attribute__((ext_vector_type(8)));
typedef int i32x4_t __attribute__((ext_vector_type(4)));
template <class Epi, bool MID, bool FP8 = false>
__device__ __forceinline__ void gemm_phase(LAS unsigned char* lds, const Gemm g, const StaticOrder& S, const Epi& E) {
    const int tid = threadIdx.x, wid = __builtin_amdgcn_readfirstlane(tid >> 6), lane = tid & 63, wr = wid >> 2, wc = wid & 3, fr = lane & 15, fq = lane >> 4;
    const int K = g.K, nt = K / BK;
    unsigned voffA[2], voffB[2];
#pragma unroll
    for (int i = 0; i < 2; ++i) { int R, C; stage_rc(tid * 16 + i * 8192, R, C); const int Rb = Epi::PERM ? ((R & ~31) + perm32(R & 31)) : R;
        voffA[i] = (unsigned)(R * K + C) * 2u; voffB[i] = (unsigned)(Rb * K + C) * 2u; }
    const size_t kstep = (size_t)(BK * 2);
    const size_t hstep = (size_t)HALF * K * 2;
    const size_t tstep = 2 * hstep;
    const unsigned ldsw = (unsigned)wid * 1024u;
    const int lds0 = (int)(unsigned)(uintptr_t)lds;
    const int aoff = lds0 + lds_byte(wr * 64 + fr, fq * 8), boff = lds0 + 4 * HTB + lds_byte(wc * 32 + fr, fq * 8);
#define PG8_SA(b, h) (((b) * 2 + (h)) * HTB)
#define PG8_SB(b, h) ((4 + (b) * 2 + (h)) * HTB)
#define PG8_STAGE(bufoff, gbase, voff) do { const long long d_ = (const char*)(gbase) - prev##voff; prev##voff = (const char*)(gbase); \
        _Pragma("unroll") for (int _i = 0; _i < 2; ++_i) { p##voff[_i] += d_; asm volatile("" : "+v"(p##voff[_i])); \
        __builtin_amdgcn_global_load_lds((const unsigned*)p##voff[_i], (LAS unsigned*)(lds + (bufoff) + ldsw + _i * 8192), 16, 0, 0); } } while (0)
#define PG8_DSR(dst, base, off) asm volatile("ds_read_b128 %0, %1 offset:%2" : "=v"(dst) : "v"(base), "i"(off))
#define PG8_LDA(dst, b, h) do { if constexpr (FP8) { _Pragma("unroll") for (int m = 0; m < 4; ++m) { i32x4_t lo_, hi_; PG8_DSR(lo_, aoff, PG8_SA(b, h) + m * 2048); PG8_DSR(hi_, aoff, PG8_SA(b, h) + m * 2048 + 1024); \
              dst##8[m] = __builtin_shufflevector(lo_, hi_, 0, 1, 2, 3, 4, 5, 6, 7); } } \
        else { _Pragma("unroll") for (int m = 0; m < 4; ++m) _Pragma("unroll") for (int k = 0; k < 2; ++k) PG8_DSR(dst[m][k], aoff, PG8_SA(b, h) + m * 2048 + k * 1024); } } while (0)
#define PG8_LDB(dst, b, h) do { if constexpr (FP8) { _Pragma("unroll") for (int n = 0; n < 2; ++n) { i32x4_t lo_, hi_; PG8_DSR(lo_, boff, PG8_SA(b, h) + n * 2048); PG8_DSR(hi_, boff, PG8_SA(b, h) + n * 2048 + 1024); \
              dst##8[n] = __builtin_shufflevector(lo_, hi_, 0, 1, 2, 3, 4, 5, 6, 7); } } \
        else { _Pragma("unroll") for (int n = 0; n < 2; ++n) _Pragma("unroll") for (int k = 0; k < 2; ++k) PG8_DSR(dst[n][k], boff, PG8_SA(b, h) + n * 2048 + k * 1024); } } while (0)
#define PG8_MMA(ai, bj, At, Bt) do { __builtin_amdgcn_s_setprio(1); _Pragma("unroll") for (int m = 0; m < 4; ++m) _Pragma("unroll") for (int n = 0; n < 2; ++n) { \
        if constexpr (FP8) { asm volatile("v_mfma_f32_16x16x128_f8f6f4 %0, %1, %2, %0" : "+v"(acc[ai][bj][m][n]) : "v"(Bt##8[n]), "v"(At##8[m])); }   \
        else { _Pragma("unroll") for (int k = 0; k < 2; ++k) acc[ai][bj][m][n] = __builtin_amdgcn_mfma_f32_16x16x32_bf16(Bt[n][k], At[m][k], acc[ai][bj][m][n], 0, 0, 0); } } \
        __builtin_amdgcn_s_setprio(0); } while (0)
#define PG8_WAIT_V(n) asm volatile("s_waitcnt vmcnt(" #n ")" ::: "memory")
#define PG8_WAIT_L(n) asm volatile("s_waitcnt lgkmcnt(" #n ")" ::: "memory")
#define PG8_BAR __builtin_amdgcn_s_barrier()
#define PG8_SCHED __builtin_amdgcn_sched_barrier(0)
#define PG8_KBODY(t) do { \
            const bool last = (t == nt - 2); \
            const char* a1 = cA + (size_t)(t + 1) * kstep; \
            const char* a2 = last ? nA : cA + (size_t)(t + 2) * kstep; const char* b2 = last ? nB : cB + (size_t)(t + 2) * kstep; \
            const char* a3 = a2 + kstep; const char* b3 = b2 + kstep; \
            PG8_LDB(B0, 0, 0); PG8_SCHED; PG8_LDA(At, 0, 0); PG8_STAGE(PG8_SA(1, 1), a1 + hstep, voffA); \
            PG8_WAIT_L(8); PG8_BAR; PG8_WAIT_L(0); PG8_MMA(0, 0, At, B0); PG8_BAR; PG8_SCHED; \
            PG8_LDB(B1, 0, 1); PG8_STAGE(PG8_SB(0, 0), b2, voffB); \
            PG8_BAR; PG8_WAIT_L(0); PG8_MMA(0, 1, At, B1); PG8_BAR; \
            PG8_LDA(At, 0, 1); PG8_STAGE(PG8_SA(0, 0), a2, voffA); \
            PG8_BAR; PG8_WAIT_L(0); PG8_MMA(1, 0, At, B0); PG8_BAR; PG8_SCHED; \
            PG8_STAGE(PG8_SB(0, 1), b2 + hstep, voffB); \
            PG8_WAIT_V(6); PG8_BAR; PG8_MMA(1, 1, At, B1); PG8_BAR; \
            PG8_LDB(B0, 1, 0); PG8_SCHED; PG8_LDA(At, 1, 0); PG8_STAGE(PG8_SA(0, 1), a2 + hstep, voffA); \
            PG8_WAIT_L(8); PG8_BAR; PG8_WAIT_L(0); PG8_MMA(0, 0, At, B0); PG8_BAR; PG8_SCHED; \
            PG8_LDB(B1, 1, 1); PG8_STAGE(PG8_SB(1, 0), b3, voffB); \
            PG8_BAR; PG8_WAIT_L(0); PG8_MMA(0, 1, At, B1); PG8_BAR; \
            PG8_LDA(At, 1, 1); PG8_STAGE(PG8_SA(1, 0), a3, voffA); \
            PG8_BAR; PG8_WAIT_L(0); PG8_MMA(1, 0, At, B0); PG8_BAR; PG8_SCHED; \
            PG8_STAGE(PG8_SB(1, 1), b3 + hstep, voffB); \
            PG8_WAIT_V(6); PG8_BAR; PG8_MMA(1, 1, At, B1); PG8_BAR; \
        } while (0)
    Unit cur, nxt; int ui = 0;
    if (!S.next(0, cur)) return;
    f32x4 acc[2][2][4][2];
#pragma unroll
    for (int a = 0; a < 2; ++a)
#pragma unroll
        for (int b = 0; b < 2; ++b)
#pragma unroll
            for (int m = 0; m < 4; ++m)
#pragma unroll
                for (int n = 0; n < 2; ++n) acc[a][b][m][n] = (f32x4){0.f, 0.f, 0.f, 0.f};
    bf16x8 At[4][2], B0[2][2], B1[2][2]; i32x8 At8[4], B08[2], B18[2];
    const char* cA = (const char*)g.A + (size_t)cur.pm * tstep; const char* cB = (const char*)g.Bt + (size_t)cur.pn * tstep;
    const char* prevvoffA = cA; const char* prevvoffB = cB;
    const char* pvoffA[2] = {cA + voffA[0], cA + voffA[1]}; const char* pvoffB[2] = {cB + voffB[0], cB + voffB[1]};
    PG8_STAGE(PG8_SB(0, 0), cB, voffB); PG8_STAGE(PG8_SA(0, 0), cA, voffA); PG8_STAGE(PG8_SB(0, 1), cB + hstep, voffB); PG8_STAGE(PG8_SA(0, 1), cA + hstep, voffA);
    if (wr == 1) PG8_BAR;
    PG8_WAIT_V(4); PG8_BAR;
    PG8_STAGE(PG8_SB(1, 0), cB + kstep, voffB); PG8_STAGE(PG8_SA(1, 0), cA + kstep, voffA); PG8_STAGE(PG8_SB(1, 1), cB + hstep + kstep, voffB);
    PG8_WAIT_V(6); PG8_BAR;
    for (;;) {
        const bool has_next = S.next(ui + 1, nxt);
        const char* nA = has_next ? (const char*)g.A + (size_t)nxt.pm * tstep : cA; const char* nB = has_next ? (const char*)g.Bt + (size_t)nxt.pn * tstep : cB;
        if constexpr (MID) {
            for (int t = 0; t < (nt >> 1); t += 2) PG8_KBODY(t);
            PG8_SCHED; if constexpr (FP8) { asm volatile("s_nop 15\n\ts_nop 15" ::: "memory"); } E.mid(acc, cur, wr, wc, fr, fq); PG8_SCHED;
            for (int t = (nt >> 1); t < nt; t += 2) PG8_KBODY(t);
        } else {
            for (int t = 0; t < nt; t += 2) PG8_KBODY(t);
        }
        if constexpr (FP8) { asm volatile("s_nop 15\n\ts_nop 15" ::: "memory"); }
        E(acc, cur, wr, wc, fr, fq);
        __builtin_amdgcn_s_waitcnt(0x0F70);
        if (!has_next) break;
#pragma unroll
        for (int a = 0; a < 2; ++a)
#pragma unroll
            for (int b = 0; b < 2; ++b)
#pragma unroll
                for (int m = 0; m < 4; ++m)
#pragma unroll
                    for (int n = 0; n < 2; ++n) acc[a][b][m][n] = (f32x4){0.f, 0.f, 0.f, 0.f};
        cur = nxt; cA = nA; cB = nB; ++ui;
    }
    PG8_WAIT_V(0);
    if (wr == 0) PG8_BAR;
    PG8_BAR;
#undef PG8_KBODY
#undef PG8_DSR
#undef PG8_SA
#undef PG8_SB
#undef PG8_STAGE
#undef PG8_LDA
#undef PG8_LDB
#undef PG8_MMA
#undef PG8_WAIT_V
#undef PG8_WAIT_L
#undef PG8_BAR
#undef PG8_SCHED
}

__device__ __forceinline__ float clampl(float l) { return fminf(fmaxf(l, -30.f), 30.f); }
struct EpiProj {
    static constexpr bool PERM = true;
    bf16_t* hm; bf16_t* gbuf; const float* b_gate; float* ksum; int mode; float scale;
    __device__ __forceinline__ void operator()(const f32x4 (&acc)[2][2][4][2], const Unit& un, int wr, int wc, int fr, int fq) const {
        Unit u; u.pm = un.pm; u.pn = mode ? un.pn + 16 : un.pn;
        const int row0 = u.pm * BM + wr * 64 + fr;
        if (u.pn >= 8 && u.pn < 16) {
#pragma unroll
            for (int bj = 0; bj < 2; ++bj)
#pragma unroll
                for (int n = 0; n < 2; ++n) { f32x4 sm = acc[0][bj][0][n];
#pragma unroll
                    for (int m = 1; m < 4; ++m) sm += acc[0][bj][m][n];
#pragma unroll
                    for (int m = 0; m < 4; ++m) sm += acc[1][bj][m][n];
#pragma unroll
                    for (int j = 0; j < 4; ++j) { float v = sm[j]; v += __shfl_xor(v, 1); v += __shfl_xor(v, 2); v += __shfl_xor(v, 4); v += __shfl_xor(v, 8);
                        if (fr == 0) atomicAdd(ksum + ((size_t)((u.pm >> 4) * NH + (u.pn - 8) * 2 + bj) * 16 + (u.pm & 15)) * 128 + wc * 32 + 8 * fq + 4 * n + j, v); } }
        }
        const bool isg = (u.pn >= 64);
        f32x4 bv[2][2];
#pragma unroll
        for (int bj = 0; bj < 2; ++bj)
#pragma unroll
            for (int n = 0; n < 2; ++n) bv[bj][n] = isg ? *(const f32x4*)(b_gate + (u.pn - 64) * BM + wc * 32 + 8 * fq + bj * HALF + 4 * n) : (f32x4){0.f, 0.f, 0.f, 0.f};
        bf16_t* base; size_t rstride, bjstride;
        if (isg) { base = gbuf + (size_t)row0 * LDG + (u.pn - 64) * BM + wc * 32 + 8 * fq; rstride = LDG; bjstride = HALF; }
        else { const int b = u.pm >> 4, s0 = (row0 & 4095); base = hm + (size_t)(u.pn >> 3) * HM_REG + ((size_t)(b * NH + (u.pn & 7) * 2) * SEQ + s0) * 128 + wc * 32 + 8 * fq; rstride = 128; bjstride = (size_t)SEQ * 128; }
#pragma unroll
        for (int ai = 0; ai < 2; ++ai)
#pragma unroll
            for (int m = 0; m < 4; ++m) { bf16_t* rowp = base + (size_t)(ai * HALF + m * 16) * rstride;
#pragma unroll
                for (int bj = 0; bj < 2; ++bj) { f32x4 v0 = acc[ai][bj][m][0] * scale, v1 = acc[ai][bj][m][1] * scale;
                    if (isg) {
#pragma unroll
                        for (int j = 0; j < 4; ++j) { v0[j] = __builtin_amdgcn_rcpf(1.f + __builtin_amdgcn_exp2f(-LOG2E * clampl(v0[j] + bv[bj][0][j])));
                                                      v1[j] = __builtin_amdgcn_rcpf(1.f + __builtin_amdgcn_exp2f(-LOG2E * clampl(v1[j] + bv[bj][1][j]))); } }
                    u32x4 w; w.x = cvt_pk_bf16(v0[0], v0[1]); w.y = cvt_pk_bf16(v0[2], v0[3]); w.z = cvt_pk_bf16(v1[0], v1[1]); w.w = cvt_pk_bf16(v1[2], v1[3]);
                    *(u32x4*)(rowp + bj * bjstride) = w; } }
    }
};
struct EpiMerged {
    static constexpr bool PERM = true;
    bf16_t* O; const bf16_t* gb;
    __device__ __forceinline__ void mid(f32x4 (&acc)[2][2][4][2], const Unit& u, int wr, int wc, int fr, int fq) const {
        const bf16_t* gp = gb + (size_t)(u.pm * BM + wr * 64 + fr) * LDG + u.pn * BM + wc * 32 + 8 * fq;
#pragma unroll
        for (int ai = 0; ai < 2; ++ai)
#pragma unroll
            for (int m = 0; m < 4; ++m)
#pragma unroll
                for (int bj = 0; bj < 2; ++bj) { const bf16_t* p = gp + (size_t)(ai * HALF + m * 16) * LDG + bj * HALF;
                    const u32x4 a = *(const u32x4*)p, b = *(const u32x4*)(p + DM);
                    acc[ai][bj][m][0][0] *= bflo(a.x) * __builtin_amdgcn_rcpf(bflo(b.x)); acc[ai][bj][m][0][1] *= bfhi(a.x) * __builtin_amdgcn_rcpf(bfhi(b.x));
                    acc[ai][bj][m][0][2] *= bflo(a.y) * __builtin_amdgcn_rcpf(bflo(b.y)); acc[ai][bj][m][0][3] *= bfhi(a.y) * __builtin_amdgcn_rcpf(bfhi(b.y));
                    acc[ai][bj][m][1][0] *= bflo(a.z) * __builtin_amdgcn_rcpf(bflo(b.z)); acc[ai][bj][m][1][1] *= bfhi(a.z) * __builtin_amdgcn_rcpf(bfhi(b.z));
                    acc[ai][bj][m][1][2] *= bflo(a.w) * __builtin_amdgcn_rcpf(bflo(b.w)); acc[ai][bj][m][1][3] *= bfhi(a.w) * __builtin_amdgcn_rcpf(bfhi(b.w));
                    __builtin_amdgcn_sched_barrier(0); }
    }
    __device__ __forceinline__ void operator()(const f32x4 (&acc)[2][2][4][2], const Unit& u, int wr, int wc, int fr, int fq) const {
        const int row0 = u.pm * BM + wr * 64 + fr, col0 = u.pn * BM + wc * 32 + 8 * fq;
        const bf16_t* gp = gb + (size_t)row0 * LDG + DM + col0;
        constexpr float F = SC_M / (SC_Y * SC_WB);
#pragma unroll
        for (int ai = 0; ai < 2; ++ai)
#pragma unroll
            for (int m = 0; m < 4; ++m)
#pragma unroll
                for (int bj = 0; bj < 2; ++bj) { const u32x4 b = *(const u32x4*)(gp + (size_t)(ai * HALF + m * 16) * LDG + bj * HALF);
                    const f32x4 v0 = acc[ai][bj][m][0] * F, v1 = acc[ai][bj][m][1] * F;
                    u32x2 w; w.x = pk4_fp8(v0[0] * bflo(b.x), v0[1] * bfhi(b.x), v0[2] * bflo(b.y), v0[3] * bfhi(b.y));
                    w.y = pk4_fp8(v1[0] * bflo(b.z), v1[1] * bfhi(b.z), v1[2] * bflo(b.w), v1[3] * bfhi(b.w));
                    *(u32x2*)((unsigned char*)O + (size_t)(row0 + ai * HALF + m * 16) * DM + col0 + bj * HALF) = w; }
    }
};
struct EpiOut {
    static constexpr bool PERM = true;
    bf16_t* O;
    __device__ __forceinline__ void operator()(const f32x4 (&acc)[2][2][4][2], const Unit& u, int wr, int wc, int fr, int fq) const {
        const int row0 = u.pm * BM + wr * 64 + fr, col0 = u.pn * BM + wc * 32 + 8 * fq;
#pragma unroll
        for (int ai = 0; ai < 2; ++ai)
#pragma unroll
            for (int m = 0; m < 4; ++m) { bf16_t* rowp = O + (size_t)(row0 + ai * HALF + m * 16) * DM + col0;
#pragma unroll
                for (int bj = 0; bj < 2; ++bj) { constexpr float F = 1.f / (SC_M * SC_WO); const f32x4 v0 = acc[ai][bj][m][0] * F, v1 = acc[ai][bj][m][1] * F;
                    u32x4 w; w.x = cvt_pk_bf16(v0[0], v0[1]); w.y = cvt_pk_bf16(v0[2], v0[3]); w.z = cvt_pk_bf16(v1[0], v1[1]); w.w = cvt_pk_bf16(v1[2], v1[3]);
                    *(u32x4*)(rowp + bj * HALF) = w; } }
    }
};
}

struct TrDesc { const float* src; size_t ld_src; bf16_t* dst; size_t ld_dst; float f8scale; };
constexpr int TR_A = 32 * 256, TR_B = 32 * 128, TR_C = 2 * 16 * 64, TR_D = 32 * 64, TR_T = TR_A + TR_B + TR_C + TR_D;
__device__ __forceinline__ TrDesc tr_desc(const Params& P, int t) {
    TrDesc d;
    if (t < TR_A) { const int kt = t & 31, nt = t >> 5, c = nt * 64, r = c >> 11, within = c & 2047;
        d.src = P.w_in + (size_t)(kt * 128) * INCOLS + c; d.ld_src = INCOLS; d.ld_dst = DM;
        if (r >= 2) { d.dst = (bf16_t*)(P.WinT8 + (size_t)((r - 2) * 2048 + within) * DM + kt * 128); d.f8scale = SC_W1; }
        else { d.dst = P.WinT + (size_t)(r * 2048 + within) * DM + kt * 128; d.f8scale = 0.f; } }
    else if (t < TR_A + TR_B) { const int u = t - TR_A, kt = u & 31, nt = u >> 5; d.src = P.w_in + (size_t)(kt * 128) * INCOLS + 16400 + nt * 64; d.ld_src = INCOLS;
        d.dst = (bf16_t*)(P.WinT8 + (size_t)(12288 + nt * 64) * DM + kt * 128); d.ld_dst = DM; d.f8scale = SC_W1; }
    else if (t < TR_A + TR_B + TR_C) { const int u = t - TR_A - TR_B, br = u >> 10, v = u & 1023, kt = v & 15, nt = v >> 4;
        d.src = P.w_branch + (size_t)br * 2048 * DM + (size_t)(kt * 128) * DM + nt * 64; d.ld_src = DM; d.dst = (bf16_t*)((unsigned char*)P.WbrT + (size_t)(nt * 64) * DM + br * 2048 + kt * 128); d.ld_dst = DM; d.f8scale = SC_WB; }
    else { const int u = t - TR_A - TR_B - TR_C, kt = u & 31, nt = u >> 5; d.src = P.w_out + (size_t)(kt * 128) * DM + nt * 64; d.ld_src = DM; d.dst = (bf16_t*)((unsigned char*)P.WoutT + (size_t)(nt * 64) * DM + kt * 128); d.ld_dst = DM; d.f8scale = SC_WO; }
    return d;
}
__device__ void phase_prologue(const Params& P, char* lds) {
    const int tid = threadIdx.x, lane = tid & 63, wid = tid >> 6;
    for (int i = blockIdx.x * 512 + tid; i < 1024 * 128 / 4; i += gridDim.x * 512) *(f32x4*)(P.kmean + (size_t)i * 4) = (f32x4){0.f, 0.f, 0.f, 0.f};
    constexpr int PW = 8208;
    for (int k = tid; k < DM; k += 512) { const float* wp = P.w_in + (size_t)k * INCOLS + 16384;
        const f32x4 w0 = *(const f32x4*)wp, w1 = *(const f32x4*)(wp + 4), w2 = *(const f32x4*)(wp + 8), w3 = *(const f32x4*)(wp + 12);
        const float wv[16] = {w0[0], w0[1], w0[2], w0[3], w1[0], w1[1], w1[2], w1[3], w2[0], w2[1], w2[2], w2[3], w3[0], w3[1], w3[2], w3[3]};
#pragma unroll
        for (int n = 0; n < 16; ++n) *(bf16_t*)(lds + n * PW + k * 2) = (bf16_t)cvt_pk_bf16(wv[n], 0.f); }
    __syncthreads();
    f32x4* comb = (f32x4*)(lds + 16 * PW);
    { const int tb = wid & 3, kh = wid >> 2, r = lane & 15, kq = lane >> 4;
      for (int rt0 = blockIdx.x * 4; rt0 < NTOK / 16; rt0 += gridDim.x * 4) {
          const int rt = rt0 + tb; f32x4 acc = {0.f, 0.f, 0.f, 0.f};
          const float* xp = P.x + (size_t)(rt * 16 + r) * DM + kh * 2048 + kq * 8; bf16_t* xo = P.xb + (size_t)(rt * 16 + r) * DM + kh * 2048 + kq * 8; unsigned char* x8o = P.x8 + (size_t)(rt * 16 + r) * DM + kh * 2048 + kq * 8;
          const char* wl = lds + r * PW + (kh * 2048 + kq * 8) * 2;
#pragma unroll 4
          for (int ks = 0; ks < 64; ++ks) { const f32x4 a0 = *(const f32x4*)(xp + ks * 32), a1 = *(const f32x4*)(xp + ks * 32 + 4);
              u32x4 w = {cvt_pk_bf16(a0[0], a0[1]), cvt_pk_bf16(a0[2], a0[3]), cvt_pk_bf16(a1[0], a1[1]), cvt_pk_bf16(a1[2], a1[3])};
              *(u32x4*)(xo + ks * 32) = w;
              { u32x2 w8 = {pk4_fp8(a0[0], a0[1], a0[2], a0[3]), pk4_fp8(a1[0], a1[1], a1[2], a1[3])}; *(u32x2*)(x8o + ks * 32) = w8; }
              const bf16x8 bfr = *(const bf16x8*)(wl + ks * 64);
              acc = __builtin_amdgcn_mfma_f32_16x16x32_bf16(*reinterpret_cast<bf16x8*>(&w), bfr, acc, 0, 0, 0); }
          if (kh == 1) comb[tb * 64 + lane] = acc;
          __syncthreads();
          if (kh == 0) { acc += comb[tb * 64 + lane]; const int s0 = rt * 16, bb = s0 >> 12, sl = s0 & 4095;
              *(f32x4*)(P.flogT + (size_t)(bb * NH + r) * SEQ + sl + kq * 4) = acc; }
          __syncthreads();
      } }
    constexpr int PB = 264;
    const int nq = tid & 15, kb = tid >> 4;
    int t = blockIdx.x; f32x4 r0, r1, r2, r3;
    if (t < TR_T) { const TrDesc d = tr_desc(P, t); const float* sp = d.src + (size_t)(kb * 4) * d.ld_src + nq * 4;
        r0 = *(const f32x4*)sp; r1 = *(const f32x4*)(sp + d.ld_src); r2 = *(const f32x4*)(sp + 2 * d.ld_src); r3 = *(const f32x4*)(sp + 3 * d.ld_src); }
    while (t < TR_T) {
        const TrDesc d = tr_desc(P, t);
        const bool f8 = d.f8scale != 0.f;
        if (!f8) {
#pragma unroll
            for (int i = 0; i < 4; ++i) { u32x2 w; w.x = cvt_pk_bf16(r0[i], r1[i]); w.y = cvt_pk_bf16(r2[i], r3[i]); *(u32x2*)(lds + (nq * 4 + i) * PB + kb * 8) = w; }
        } else { const float sc = d.f8scale;
#pragma unroll
            for (int i = 0; i < 4; ++i) *(unsigned*)(lds + (nq * 4 + i) * 144 + kb * 4) = pk4_fp8(r0[i] * sc, r1[i] * sc, r2[i] * sc, r3[i] * sc);
        }
        __syncthreads();
        const int tn = t + (int)gridDim.x;
        if (tn < TR_T) { const TrDesc dn = tr_desc(P, tn); const float* sp = dn.src + (size_t)(kb * 4) * dn.ld_src + nq * 4;
            r0 = *(const f32x4*)sp; r1 = *(const f32x4*)(sp + dn.ld_src); r2 = *(const f32x4*)(sp + 2 * dn.ld_src); r3 = *(const f32x4*)(sp + 3 * dn.ld_src); }
        if (!f8) {
#pragma unroll
            for (int i = 0; i < 2; ++i) { const int id = tid + i * 512, n = id >> 4, c = id & 15;
                const u32x2 a = *(const u32x2*)(lds + n * PB + c * 16), b2 = *(const u32x2*)(lds + n * PB + c * 16 + 8);
                u32x4 w = {a.x, a.y, b2.x, b2.y}; *(u32x4*)(d.dst + (size_t)n * d.ld_dst + c * 8) = w; }
        } else { const int n = tid >> 3, c = tid & 7;
            *(u32x4*)((unsigned char*)d.dst + (size_t)n * d.ld_dst + c * 16) = *(const u32x4*)(lds + n * 144 + c * 16); }
        __syncthreads();
        t = tn;
    }
}

__device__ void phase_stats(const Params& P, char* lds) {
    const int tid = threadIdx.x;
    float* red = (float*)lds;
    for (int id = blockIdx.x; id < 1024; id += gridDim.x) {
        const int n = id & 15, h = (id >> 4) & 15, b = id >> 8;
        const int rg = tid >> 4, ch = tid & 15;
        float a[8] = {0, 0, 0, 0, 0, 0, 0, 0};
#pragma unroll
        for (int i = 0; i < 8; ++i) { const u32x4 w = *(const u32x4*)(P.hm + 1 * HM_REG + ((size_t)(b * NH + h) * SEQ + n * 256 + rg + 32 * i) * 128 + ch * 8);
            a[0] += bflo(w.x); a[1] += bfhi(w.x); a[2] += bflo(w.y); a[3] += bfhi(w.y); a[4] += bflo(w.z); a[5] += bfhi(w.z); a[6] += bflo(w.w); a[7] += bfhi(w.w); }
#pragma unroll
        for (int j = 0; j < 8; ++j) red[rg * 128 + ch * 8 + j] = a[j];
        __syncthreads();
        if (tid < 128) { float sm = 0.f; for (int r = 0; r < 32; ++r) sm += red[r * 128 + tid]; P.kmean[(size_t)id * 128 + tid] = sm * (1.f / 256.f); }
        __syncthreads();
    }
}

constexpr int SHM_K = 16384, SHM_V = 16384;
#define KSWZ(row, colB) ((row) * 256 + ((colB) ^ (((row) & 7) << 4)))
#define SBAR() __builtin_amdgcn_sched_barrier(0)
__device__ __forceinline__ int v_st(int k, int c) { const int kk = (k & ~0xC) | ((k & 4) << 1) | ((k & 8) >> 1); return ((kk >> 3) * 4 + (c >> 5)) * 512 + ((kk & 7) * 32 + (c & 31)) * 2; }
__device__ __forceinline__ int v_rd_base(int lane) { return ((lane & 3) << 3) | (((lane >> 2) & 3) << 6) | (((lane >> 4) & 1) << 5) | (((lane >> 5) & 1) << 8); }
constexpr int v_rd_off(int d0, int ks, int half) { return d0 * 512 + ks * 4096 + half * 2048; }
__device__ __forceinline__ int crow(int r, int hi) { return (r & 3) + 8 * (r >> 2) + 4 * hi; }

template <int KB>
__device__ __forceinline__ void qkt(f32x16& p0, f32x16& p1, const char* K_lds, int r32, int hi, const bf16x8* qr) {
    const char* kb[4];
#pragma unroll
    for (int dd = 0; dd < 4; ++dd) kb[dd] = K_lds + KB * SHM_K + KSWZ(r32, (dd * 16 + hi * 8) * 2);
#pragma unroll
    for (int d0 = 0; d0 < 8; ++d0) { const char* a = kb[d0 & 3] + (d0 >> 2) * 128;
        bf16x8 b0 = *reinterpret_cast<const bf16x8*>(a);
        bf16x8 b1 = *reinterpret_cast<const bf16x8*>(a + 32 * 256);
        p0 = __builtin_amdgcn_mfma_f32_32x32x16_bf16(b0, qr[d0], p0, 0, 0, 0);
        p1 = __builtin_amdgcn_mfma_f32_32x32x16_bf16(b1, qr[d0], p1, 0, 0, 0); }
}
template <int VB>
__device__ __forceinline__ void pv_tile(f32x16* o, int vb0, bf16x8 pa0, bf16x8 pa1, bf16x8 pa2, bf16x8 pa3) {
#define TRRD(dst, off) asm volatile("ds_read_b64_tr_b16 %0, %1 offset:%2" : "=&v"(dst) : "v"(vb0), "i"(off) : "memory")
#define PV_D0(d0) do { s16x4 l0, l1, l2, l3, h0, h1, h2, h3; constexpr int b_ = VB * SHM_V + v_rd_off(d0, 0, 0); \
        TRRD(l0, b_); TRRD(h0, b_ + 2048); TRRD(l1, b_ + 4096); TRRD(h1, b_ + 6144); TRRD(l2, b_ + 8192); TRRD(h2, b_ + 10240); TRRD(l3, b_ + 12288); TRRD(h3, b_ + 14336); \
        asm volatile("s_waitcnt lgkmcnt(0)" ::: "memory"); SBAR(); \
        o[d0] = __builtin_amdgcn_mfma_f32_32x32x16_bf16(pa0, (bf16x8){l0[0], l0[1], l0[2], l0[3], h0[0], h0[1], h0[2], h0[3]}, o[d0], 0, 0, 0);   \
        o[d0] = __builtin_amdgcn_mfma_f32_32x32x16_bf16(pa1, (bf16x8){l1[0], l1[1], l1[2], l1[3], h1[0], h1[1], h1[2], h1[3]}, o[d0], 0, 0, 0);   \
        o[d0] = __builtin_amdgcn_mfma_f32_32x32x16_bf16(pa2, (bf16x8){l2[0], l2[1], l2[2], l2[3], h2[0], h2[1], h2[2], h2[3]}, o[d0], 0, 0, 0);   \
        o[d0] = __builtin_amdgcn_mfma_f32_32x32x16_bf16(pa3, (bf16x8){l3[0], l3[1], l3[2], l3[3], h3[0], h3[1], h3[2], h3[3]}, o[d0], 0, 0, 0); } while (0)
    PV_D0(0); PV_D0(1); PV_D0(2); PV_D0(3);
#undef PV_D0
#undef TRRD
}
typedef __bf16 bf16x2_t __attribute__((ext_vector_type(2)));
__device__ __forceinline__ unsigned pk2(float lo, float hi) { f32x2 v = {lo, hi}; bf16x2_t b = __builtin_convertvector(v, bf16x2_t); return *reinterpret_cast<unsigned*>(&b); }
template <bool SK>
__device__ __forceinline__ bool softmax_tile(f32x16& p0, f32x16& p1, float tc, float& m_reg, float& l_reg, float& alpha, bf16x8& pa0, bf16x8& pa1, bf16x8& pa2, bf16x8& pa3) {
    float pmax = p0[0];
#pragma unroll
    for (int r = 1; r < 16; ++r) pmax = fmaxf(pmax, p0[r]);
#pragma unroll
    for (int r = 0; r < 16; ++r) pmax = fmaxf(pmax, p1[r]);
    { auto rr = __builtin_amdgcn_permlane32_swap(__float_as_uint(pmax), __float_as_uint(pmax), false, false);
      pmax = fmaxf(__uint_as_float(rr[0]), __uint_as_float(rr[1])); }
    constexpr float C2s = LOG2E * ATT_SCALE;
    const float smax = fmaf(pmax, C2s, tc);
    if (SK && __all(smax - m_reg < -151.f)) { alpha = 1.f; return false; }
    const bool keep = __all(smax - m_reg <= 11.5f);
    const float mn = keep ? m_reg : fmaxf(m_reg, smax);
    alpha = __builtin_amdgcn_exp2f(m_reg - mn); m_reg = mn;
    const float mnl = tc - mn;
#pragma unroll
    for (int r = 0; r < 16; ++r) p0[r] = __builtin_amdgcn_exp2f(fmaf(p0[r], C2s, mnl));
#pragma unroll
    for (int r = 0; r < 16; ++r) p1[r] = __builtin_amdgcn_exp2f(fmaf(p1[r], C2s, mnl));
    float ps = 0;
#pragma unroll
    for (int r = 0; r < 16; ++r) ps += p0[r];
#pragma unroll
    for (int r = 0; r < 16; ++r) ps += p1[r];
    { auto rr = __builtin_amdgcn_permlane32_swap(__float_as_uint(ps), __float_as_uint(ps), false, false);
      ps = __uint_as_float(rr[0]) + __uint_as_float(rr[1]); }
    l_reg = l_reg * alpha + ps;
#define PK4(P, B_, OUT) do { unsigned a0 = pk2(P[B_+0], P[B_+1]), a1 = pk2(P[B_+2], P[B_+3]);                          \
        unsigned b0 = pk2(P[B_+4], P[B_+5]), b1 = pk2(P[B_+6], P[B_+7]);                                             \
        auto r0 = __builtin_amdgcn_permlane32_swap(a0, b0, false, false); auto r1 = __builtin_amdgcn_permlane32_swap(a1, b1, false, false); \
        u32x4 w = {r0[0], r1[0], r0[1], r1[1]}; OUT = *reinterpret_cast<bf16x8*>(&w); } while (0)
    PK4(p0, 0, pa0); PK4(p0, 8, pa1); PK4(p1, 0, pa2); PK4(p1, 8, pa3);
#undef PK4
    return true;
}
__device__ __forceinline__ int t5_bucket(int d) {
    if (d < 16) return d;
    const float v = logf((float)d * (1.f / 16.f)) / 2.0794415416798357f * 16.f;
    const int l = 16 + (int)v; return l < 31 ? l : 31;
}

template <int TYPE>
__device__ __forceinline__ void attn_block(const Params& P, char* lds, int b, int h, int qb) {
    int tid_ = threadIdx.x; asm volatile("" : "+v"(tid_));
    const int tid = tid_, wid = __builtin_amdgcn_readfirstlane(tid >> 6), lane = tid & 63, r32 = lane & 31, hi = lane >> 5;
    const size_t tok0 = (size_t)b * SEQ, hs0 = (size_t)(b * NH + h) * SEQ * 128;
    const bf16_t* Qp = P.hm + (TYPE * 4 + 0) * HM_REG + hs0 + (size_t)qb * 256 * 128;
    const bf16_t* Kp = P.hm + (TYPE * 4 + 1) * HM_REG + hs0;
    const bf16_t* Vp = P.hm + (TYPE * 4 + 2) * HM_REG + hs0;
    const bf16_t* Zp = P.hm + (TYPE * 4 + 3) * HM_REG + hs0 + (size_t)qb * 256 * 128;
    unsigned char* Yp = (unsigned char*)P.Y + (tok0 + qb * 256) * DM + TYPE * 2048 + h * 128;
    char* V_lds = lds; char* K_lds = lds + 3 * SHM_V;
    float* ws = (float*)(lds + 98304) + wid * 64; float* li_l = ws; float* al_l = ws + 32;
    float* cbuf = (float*)(lds + 98304 + 2048); float* relb = cbuf + 4096;
    const int NT = (qb + 1) * 4;
    const int qlo = qb * 256 + wid * 32, qpos = qlo + r32;
    constexpr float C2 = LOG2E * ATT_SCALE;
    const float NEG = -__builtin_inff();

    bf16x8 qr[8];
#pragma unroll
    for (int d0 = 0; d0 < 8; ++d0) qr[d0] = *(const bf16x8*)(Qp + (size_t)(wid * 32 + r32) * 128 + d0 * 16 + hi * 8);

    unsigned sel = 0; float b31 = 0.f;
    if constexpr (TYPE == 0) {
        if (tid < 128) cbuf[tid] = P.rel_bias[t5_bucket(tid) * NH + h] * (1.f / ATT_SCALE);
        { const int row = tid >> 4, ch = tid & 15, n = row & 15;
          const float* km = P.kmean + ((size_t)((b * NH + h) * 16 + n)) * 128 + ch * 8;
          const f32x4 a = *(const f32x4*)km, c = *(const f32x4*)(km + 4);
          float v[8] = {a[0], a[1], a[2], a[3], c[0], c[1], c[2], c[3]};
          if (row >= 16) {
#pragma unroll
              for (int j = 0; j < 8; ++j) { const float hf = __uint_as_float(cvt_pk_bf16(v[j], 0.f) << 16); v[j] = v[j] - hf; } }
          u32x4 w = {cvt_pk_bf16(v[0], v[1]), cvt_pk_bf16(v[2], v[3]), cvt_pk_bf16(v[4], v[5]), cvt_pk_bf16(v[6], v[7])};
          *(u32x4*)(K_lds + KSWZ(row, ch * 16)) = w; }
        __syncthreads();
        f32x16 g = f32x16{};
        { const char* kb[4];
#pragma unroll
          for (int dd = 0; dd < 4; ++dd) kb[dd] = K_lds + KSWZ(r32, (dd * 16 + hi * 8) * 2);
#pragma unroll
          for (int d0 = 0; d0 < 8; ++d0) { const bf16x8 a = *reinterpret_cast<const bf16x8*>(kb[d0 & 3] + (d0 >> 2) * 128);
              g = __builtin_amdgcn_mfma_f32_32x32x16_bf16(a, qr[d0], g, 0, 0, 0); } }
        float ga[16];
#pragma unroll
        for (int r = 0; r < 8; ++r) { const float mine = g[r] + g[r + 8]; const float oth = __shfl_xor(mine, 32);
            const int nb = (r & 3) + 8 * (r >> 2); ga[nb] = hi ? oth : mine; ga[nb + 4] = hi ? mine : oth; }
#pragma unroll
        for (int pass = 0; pass < 3; ++pass) { float best = NEG; int bi = -1;
#pragma unroll
            for (int n = 0; n < 16; ++n) { const bool ok = (n < qb) && !((sel >> n) & 1u) && (ga[n] > best); best = ok ? ga[n] : best; bi = ok ? n : bi; }
            if (bi >= 0) sel |= 1u << bi; }
        b31 = cbuf[127];
        __syncthreads();
    } else {
        const float* fl = P.flogT + (size_t)(b * NH + h) * SEQ; const float bfg = P.b_forget[h];
        float* sred = (float*)(lds + 98304 + 2048 + 32768);
        const bool in = tid * 8 < (qb + 1) * 256;
        float v[8]; float run = 0.f;
        if (in) { const f32x4 a = *(const f32x4*)(fl + tid * 8), c = *(const f32x4*)(fl + tid * 8 + 4);
            const float zz[8] = {a[0], a[1], a[2], a[3], c[0], c[1], c[2], c[3]};
#pragma unroll
            for (int i = 0; i < 8; ++i) { const float z = zz[i] + bfg; run += fminf(z, 0.f) - log1pf(expf(-fabsf(z))); v[i] = run; } }
        float inc = run;
#pragma unroll
        for (int off = 1; off < 64; off <<= 1) { const float ov = __shfl_up(inc, off); if (lane >= off) inc += ov; }
        if (lane == 63) sred[wid] = inc;
        __syncthreads();
        float base = inc - run;
        for (int w = 0; w < wid; ++w) base += sred[w];
        if (in) { *(f32x4*)(cbuf + tid * 8) = (f32x4){-(base + v[0]), -(base + v[1]), -(base + v[2]), -(base + v[3])};
                  *(f32x4*)(cbuf + tid * 8 + 4) = (f32x4){-(base + v[4]), -(base + v[5]), -(base + v[6]), -(base + v[7])}; }
        __syncthreads();
        constexpr float RS = 1.f / ATT_SCALE;
        if (in) { const float ref = cbuf[(tid * 8) & ~63];
            const f32x4 a = *(const f32x4*)(cbuf + tid * 8), c = *(const f32x4*)(cbuf + tid * 8 + 4);
            *(f32x4*)(relb + tid * 8) = (a - ref) * RS; *(f32x4*)(relb + tid * 8 + 4) = (c - ref) * RS; }
    }

    float m_reg = -1e30f, l_reg = 0.f; f32x16 o[4] = {};
    const int sr = tid >> 4, sc = (tid & 15) * 8, vst0 = v_st(sr, sc), vst1 = v_st(32 + sr, sc), kws = KSWZ(sr, sc * 2);
    const int vb0 = (int)(uintptr_t)V_lds + v_rd_base(lane);
    LAS unsigned char* ldsa = (LAS unsigned char*)(unsigned)(uintptr_t)lds;
    const int dk_row = wid * 4 + (lane >> 4), dk_col = ((((lane & 15) * 16) ^ ((dk_row & 7) << 4)) >> 1);
    const bf16_t* kg0 = Kp + (size_t)dk_row * 128 + dk_col;
    const int kkv = (wid >> 1) * 8 + ((lane & 31) >> 2), dv_k = (kkv & ~0xC) | ((kkv & 4) << 1) | ((kkv & 8) >> 1), dv_c = ((wid & 1) * 2 + (lane >> 5)) * 32 + (lane & 3) * 8;
    const bf16_t* vg0 = Vp + (size_t)dv_k * 128 + dv_c;
#define DMAK(k0, bf) do { _Pragma("unroll") for (int _i = 0; _i < 2; ++_i) __builtin_amdgcn_global_load_lds((const unsigned*)(kg0 + (size_t)((k0) + _i * 32) * 128), \
        (LAS unsigned*)(ldsa + 3 * SHM_V + (bf) * SHM_K + _i * 8192 + wid * 1024), 16, 0, 0); } while (0)
#define DMAV(k0, bf) do { _Pragma("unroll") for (int _i = 0; _i < 2; ++_i) __builtin_amdgcn_global_load_lds((const unsigned*)(vg0 + (size_t)((k0) + _i * 32) * 128), \
        (LAS unsigned*)(ldsa + (bf) * SHM_V + _i * 8192 + wid * 1024), 16, 0, 0); } while (0)
#define VMW() asm volatile("s_waitcnt vmcnt(0)" ::: "memory")
#define SGB(mask, n) __builtin_amdgcn_sched_group_barrier(mask, n, 0)
#define INITP(P0, P1, kq_, GEN) do {                                                                                                     \
        if constexpr (TYPE == 1) { const f32x4* cb = (const f32x4*)(relb + (kq_) + 4 * hi);                                               \
            _Pragma("unroll") for (int q = 0; q < 4; ++q) { const f32x4 c0 = cb[2 * q], c1 = cb[2 * q + 8];                               \
                _Pragma("unroll") for (int i = 0; i < 4; ++i) { P0[4 * q + i] = c0[i]; P1[4 * q + i] = c1[i]; } }                         \
        } else { P0 = f32x16{}; P1 = f32x16{}; } } while (0)
#define ADDB(P0, P1, kq_, GEN) do {                                                                                                      \
        if constexpr (TYPE == 1) {                                                                                                        \
        } else { const int nblk = (kq_) >> 8; const bool okl = (nblk == qb) || ((sel >> nblk) & 1u);                                     \
            if (GEN && ((kq_) + 191 > qlo)) {                                                                                             \
                _Pragma("unroll") for (int r = 0; r < 16; ++r) { const int d = qpos - (kq_) - crow(r, hi);                                \
                    const float t0 = cbuf[min(max(d, 0), 127)], t1 = cbuf[min(max(d - 32, 0), 127)];                                      \
                    P0[r] = (okl && d >= 0) ? P0[r] + t0 : NEG; P1[r] = (okl && d >= 32) ? P1[r] + t1 : NEG; }                            \
            } else { const float bl = okl ? b31 : NEG;                                                                                    \
                _Pragma("unroll") for (int r = 0; r < 16; ++r) { P0[r] += bl; P1[r] += bl; } } } } while (0)
#define STEP(t, PC0, PC1, PN0, PN1, INT) do { const int kb_ = (t) * 64; const bool moreK = INT || ((t) + 3 < NT), moreV = INT || ((t) + 2 < NT);  \
        const int i1 = (i0 == 2) ? 0 : i0 + 1, i2 = (i1 == 2) ? 0 : i1 + 1;                                                               \
        if (moreK) DMAK(kb_ + 192, i0); if (moreV) DMAV(kb_ + 128, i2);                                                                   \
        SBAR();                                                                                                                           \
        if (INT || (((t) + 1 < NT) && (kb_ + 64 <= qlo + 31))) { INITP(PN0, PN1, kb_ + 64, !(INT)); qkt<0>(PN0, PN1, K_lds + i1 * SHM_K, r32, hi, qr); } \
        if (INT || (kb_ <= qlo + 31)) {                                                                                                   \
            if constexpr (TYPE == 1) { if (!INT && (kb_ + 63 > qlo)) {                                                                    \
                    _Pragma("unroll") for (int r = 0; r < 16; ++r) { const int key = kb_ + crow(r, hi);                                   \
                        if (key > qpos) PC0[r] = NEG; if (key + 32 > qpos) PC1[r] = NEG; } } }                                            \
            ADDB(PC0, PC1, kb_, !(INT));                                                                                                  \
            float alpha; bf16x8 pa0, pa1, pa2, pa3;                                                                                       \
            const float tc_ = TYPE ? cbuf[kb_] * LOG2E : 0.f;                                                                             \
            const bool live_ = softmax_tile<TYPE == 1>(PC0, PC1, tc_, m_reg, l_reg, alpha, pa0, pa1, pa2, pa3);                           \
            SBAR();                                                                                                                       \
            if (live_) {                                                                                                                  \
            if (__any(alpha < 1.f)) { if (hi == 0) al_l[r32] = alpha; asm volatile("s_waitcnt lgkmcnt(0)" ::: "memory");                  \
                _Pragma("unroll") for (int d_ = 0; d_ < 4; ++d_) _Pragma("unroll") for (int r = 0; r < 16; ++r) o[d_][r] *= al_l[crow(r, hi)]; } \
            SBAR(); pv_tile<0>(o, vb0 + i0 * SHM_V, pa0, pa1, pa2, pa3); }                                                                \
        }                                                                                                                                 \
        if (moreK) asm volatile("s_waitcnt vmcnt(4) lgkmcnt(0)" ::: "memory"); else asm volatile("s_waitcnt vmcnt(0) lgkmcnt(0)" ::: "memory"); \
        __builtin_amdgcn_s_barrier(); asm volatile("" ::: "memory"); i0 = i1; } while (0)

    DMAK(0, 0); DMAV(0, 0); DMAK(64, 1); DMAK(128, 2); DMAV(64, 1);
    asm volatile("s_waitcnt vmcnt(4) lgkmcnt(0)" ::: "memory");
    __builtin_amdgcn_s_barrier(); asm volatile("" ::: "memory");
    if constexpr (TYPE == 1) {
        const bf16_t* kr = Kp + (size_t)(qb * 256 + wid * 32 + r32) * 128 + hi * 8; float ds = 0.f;
#pragma unroll
        for (int d0 = 0; d0 < 8; ++d0) { const bf16x8 kv = *(const bf16x8*)(kr + d0 * 16);
#pragma unroll
            for (int jj = 0; jj < 8; ++jj) ds += bf2f((bf16_t)qr[d0][jj]) * bf2f((bf16_t)kv[jj]); }
        ds += __shfl_xor(ds, 32);
        m_reg = fmaf(ds + relb[qpos], C2, cbuf[qpos & ~63] * LOG2E);
    }
    f32x16 pA0, pA1, pB0, pB1; int i0 = 0;
    INITP(pA0, pA1, 0, true); qkt<0>(pA0, pA1, K_lds, r32, hi, qr);
    const int NI = TYPE ? 4 * qb : (qb > 0 ? 4 * qb - 4 : 0);
    int j = 0;
    for (; j < NI; j += 2) { STEP(j, pA0, pA1, pB0, pB1, 1); STEP(j + 1, pB0, pB1, pA0, pA1, 1); }
    for (; j < NT; j += 2) { STEP(j, pA0, pA1, pB0, pB1, 0); STEP(j + 1, pB0, pB1, pA0, pA1, 0); }
#undef SGB
#undef INITP
#undef ADDB
#undef STEP
#undef DMAK
#undef DMAV
#undef VMW
#undef ROWP
    if (hi == 0) li_l[r32] = l_reg;
    asm volatile("s_waitcnt lgkmcnt(0)" ::: "memory");
#pragma unroll
    for (int r = 0; r < 16; ++r) { const int orow = wid * 32 + crow(r, hi); const float rl = __builtin_amdgcn_rcpf(li_l[crow(r, hi)]);
#pragma unroll
        for (int d0 = 0; d0 < 4; ++d0) { const float z = bf2f(Zp[(size_t)orow * 128 + d0 * 32 + r32]);
            const float v = o[d0][r] * rl * z * __builtin_amdgcn_rcpf(1.f + __builtin_amdgcn_exp2f(-LOG2E * z));
            const float vn = __shfl_xor(v, 1);
            const int pk = __builtin_amdgcn_cvt_pk_fp8_f32(v * SC_Y, vn * SC_Y, 0, false);
            const int pq = __shfl_xor(pk, 2);
            if ((r32 & 3) == 0) *(unsigned*)(Yp + (size_t)orow * DM + d0 * 32 + r32) = ((unsigned)pk & 0xffffu) | ((unsigned)pq << 16); } }
    __syncthreads();
}
__device__ void phase_attention(const Params& P, char* lds) {
    const int c = blockIdx.x, xcd = c & 7, s = c >> 3;
    const int nslot = (int)(gridDim.x >> 3);
    for (int i2 = 0; ; ++i2) {
        const int slot = s + (i2 >> 1) * nslot;
        if (slot >= 128) break;
        const int x = slot & 7, gidx = slot >> 3;
        const int type = gidx >> 3, bh = (gidx & 7) * 8 + xcd;
        const int b = bh >> 4, h = bh & 15, qb = (i2 & 1) ? x : 15 - x;
        if (type == 0) attn_block<0>(P, lds, b, h, qb);
        else           attn_block<1>(P, lds, b, h, qb);
    }
}

__device__ void phase_ln(const Params& P) {
    const int lane = threadIdx.x & 63, gw = blockIdx.x * 8 + (threadIdx.x >> 6), nw = gridDim.x * 8;
    for (int row = gw; row < NTOK; row += nw) {
        const float* xp = P.x + (size_t)row * DM; const bf16_t* op = P.outb + (size_t)row * DM; float* rp = P.out + (size_t)row * DM;
        f32x4 v[16]; float s = 0.f;
#pragma unroll
        for (int i = 0; i < 8; ++i) { const int c = (i * 64 + lane) * 8;
            const f32x4 x0 = *(const f32x4*)(xp + c), x1 = *(const f32x4*)(xp + c + 4); const u32x4 ob = *(const u32x4*)(op + c);
            v[2 * i] = x0 * DN_ALPHA + (f32x4){bflo(ob.x), bfhi(ob.x), bflo(ob.y), bfhi(ob.y)};
            v[2 * i + 1] = x1 * DN_ALPHA + (f32x4){bflo(ob.z), bfhi(ob.z), bflo(ob.w), bfhi(ob.w)};
            s += (v[2 * i][0] + v[2 * i][1]) + (v[2 * i][2] + v[2 * i][3]) + (v[2 * i + 1][0] + v[2 * i + 1][1]) + (v[2 * i + 1][2] + v[2 * i + 1][3]); }
#pragma unroll
        for (int off = 32; off > 0; off >>= 1) s += __shfl_xor(s, off);
        const float mu = s * (1.f / DM); float q = 0.f;
#pragma unroll
        for (int i = 0; i < 16; ++i) { const f32x4 d = v[i] - mu; q += (d[0] * d[0] + d[1] * d[1]) + (d[2] * d[2] + d[3] * d[3]); }
#pragma unroll
        for (int off = 32; off > 0; off >>= 1) q += __shfl_xor(q, off);
        const float rs = rsqrtf(q * (1.f / DM) + LN_EPS);
#pragma unroll
        for (int i = 0; i < 16; ++i) { const int c = ((i >> 1) * 64 + lane) * 8 + (i & 1) * 4; const f32x4 gn = *(const f32x4*)(P.ln_gain + c), bs = *(const f32x4*)(P.ln_bias + c);
            *(f32x4*)(rp + c) = (v[i] - mu) * rs * gn + bs; }
    }
}

#ifndef PHASE_MASK
#define PHASE_MASK 0x7f
#endif
__global__ void __launch_bounds__(512) fwd_megakernel(Params P) {
    extern __shared__ __attribute__((aligned(16))) unsigned char shm[];
    cg::grid_group grid = cg::this_grid();
    if (PHASE_MASK & 1) phase_prologue(P, (char*)shm);
    grid.sync();
    if (PHASE_MASK & 2) {
      { pg8::StaticOrder S; S.init(NTOK, 4096, (int)gridDim.x, (int)blockIdx.x);
        pg8::Gemm g{P.xb, P.WinT, NTOK, 4096, DM}; pg8::EpiProj E{P.hm, P.gbuf, P.b_gate, P.kmean, 0, 1.f};
        pg8::gemm_phase<pg8::EpiProj, false, false>((LAS unsigned char*)shm, g, S, E); }
      { pg8::StaticOrder S; S.init(NTOK, 20480, (int)gridDim.x, (int)blockIdx.x);
        pg8::Gemm g{(const bf16_t*)P.x8, (const bf16_t*)P.WinT8, NTOK, 20480, DM / 2}; pg8::EpiProj E{P.hm, P.gbuf, P.b_gate, P.kmean, 1, 1.f / SC_W1};
        pg8::gemm_phase<pg8::EpiProj, false, true>((LAS unsigned char*)shm, g, S, E); } }
    grid.sync();
    if (PHASE_MASK & 8) phase_attention(P, (char*)shm);
    grid.sync();
    if (PHASE_MASK & 16) { pg8::StaticOrder S; S.init(NTOK, DM, (int)gridDim.x, (int)blockIdx.x);
      pg8::Gemm g{P.Y, P.WbrT, NTOK, DM, DM / 2}; pg8::EpiMerged E{P.merged, P.gbuf};
      pg8::gemm_phase<pg8::EpiMerged, true, true>((LAS unsigned char*)shm, g, S, E); }
    grid.sync();
    if (PHASE_MASK & 32) { pg8::StaticOrder S; S.init(NTOK, DM, (int)gridDim.x, (int)blockIdx.x);
      pg8::Gemm g{P.merged, P.WoutT, NTOK, DM, DM / 2}; pg8::EpiOut E{P.outb};
      pg8::gemm_phase<pg8::EpiOut, false, true>((LAS unsigned char*)shm, g, S, E); }
    grid.sync();
    if (PHASE_MASK & 64) phase_ln(P);
}

extern "C" void kernel_launch(void* const* d_in, const int* in_sizes, int n_in, void* d_out, int out_size, void* d_ws, size_t ws_size, hipStream_t stream) {
    (void)in_sizes; (void)n_in; (void)out_size;
    static int grid_blocks = 0;
    if (!grid_blocks) {
        hipError_t e = hipFuncSetAttribute((const void*)fwd_megakernel, hipFuncAttributeMaxDynamicSharedMemorySize, LDS_BYTES);
        if (e != hipSuccess) fprintf(stderr, "hipFuncSetAttribute failed: %s\n", hipGetErrorString(e));
        int dev = 0, cus = 0, per_cu = 0;
        hipGetDevice(&dev);
        hipDeviceGetAttribute(&cus, hipDeviceAttributeMultiprocessorCount, dev);
        hipOccupancyMaxActiveBlocksPerMultiprocessor(&per_cu, fwd_megakernel, 512, LDS_BYTES);
        if (per_cu < 1) per_cu = 1;
        grid_blocks = cus;
        if (grid_blocks & 7) grid_blocks &= ~7;
    }
    Params p{};
    p.x = (const float*)d_in[0]; p.w_in = (const float*)d_in[1]; p.b_forget = (const float*)d_in[2]; p.b_gate = (const float*)d_in[3];
    p.rel_bias = (const float*)d_in[4]; p.w_branch = (const float*)d_in[5]; p.w_out = (const float*)d_in[6]; p.ln_gain = (const float*)d_in[7]; p.ln_bias = (const float*)d_in[8];
    p.out = (float*)d_out;
    char* w = (char*)d_ws; size_t off = 0;
    auto take = [&](size_t bytes) { char* r = w + off; off += (bytes + 255) & ~(size_t)255; return r; };
    p.xb = (bf16_t*)take((size_t)NTOK * DM * 2);
    p.merged = (bf16_t*)take((size_t)NTOK * DM * 2);
    p.outb = p.xb;
    p.x8 = (unsigned char*)p.merged + (size_t)NTOK * DM;
    p.WinT = (bf16_t*)take((size_t)LDP * DM * 2);
    p.WinT8 = (unsigned char*)p.WinT + (size_t)4096 * DM * 2;
    p.Y = (bf16_t*)take((size_t)NTOK * DM * 2);
    p.WbrT = (bf16_t*)take((size_t)DM * DM * 2);
    p.WoutT = (bf16_t*)take((size_t)DM * DM * 2);
    p.hm = (bf16_t*)take((size_t)8 * HM_REG * 2);
    p.gbuf = (bf16_t*)take((size_t)NTOK * LDG * 2);
    p.kmean = (float*)take((size_t)1024 * 128 * 4);
    p.flogT = (float*)take((size_t)64 * SEQ * 4);
    if (off > ws_size) { fprintf(stderr, "workspace too small: need %zu have %zu\n", off, ws_size); return; }
    void* args[] = {&p};
    hipError_t e = hipLaunchCooperativeKernel((const void*)fwd_megakernel, dim3(grid_blocks), dim3(512), args, LDS_BYTES, stream);
    if (e != hipSuccess) fprintf(stderr, "cooperative launch failed: %s (grid %d)\n", hipGetErrorString(e), grid_blocks);
}
```
